# Optimizing an MI355X kernel written in HIP

```python
import jax, jax.numpy as jnp
from jax import lax
import numpy as np

D_MODEL = 1024
BATCH = 32
SEQ = 256
DEPTH = 1
DEC_BATCH = 8
DEC_SEQ = 4096
PAST_LEN = 512

GRID_W = 64
N_HEADS = 8
HEAD_DIM = 64
N_KV_HEADS = 2
ATTN_W = N_HEADS * HEAD_DIM
KV_W = N_KV_HEADS * HEAD_DIM
LRU_W = D_MODEL // 2
LRU_BLOCKS = 8
LRU_BLOCK = LRU_W // LRU_BLOCKS
LRU_C = 8.0
CONV_W = 4
MIX_W = ATTN_W + LRU_W
IN_COLS = ATTN_W + 2 * KV_W + 2 * LRU_W
FFN_DIM = 2816
N_SUB = 3
Q_BLOCK = 128
ROPE_THETA = 10000.0
EPS = 1e-6

kernel_name = "hymba_rglru_gqa_macaron_prefix_dit_step"


def rms_norm(x, g):
    xf = x.astype(jnp.float32)
    y = xf * lax.rsqrt(jnp.mean(xf * xf, axis=-1, keepdims=True) + EPS)
    return (y * g.astype(jnp.float32)).astype(x.dtype)


def modulation(cond, w_mod, b_mod):
    m = jax.nn.silu(cond) @ w_mod + b_mod
    return m.reshape(-1, 1, 3 * N_SUB, D_MODEL)


def swiglu(h, w_in, w_out):
    g, u = jnp.split(h @ w_in, 2, axis=-1)
    return (jax.nn.silu(g) * u) @ w_out


def axial_rope_tables(seq_len):
    rows = seq_len // GRID_W
    r, c = jnp.meshgrid(jnp.arange(rows), jnp.arange(GRID_W), indexing="ij")
    r = r.reshape(-1).astype(jnp.float32)
    c = c.reshape(-1).astype(jnp.float32)
    n_freq = HEAD_DIM // 4
    inv = ROPE_THETA ** (-jnp.arange(n_freq, dtype=jnp.float32) / n_freq)
    ar = r[:, None] * inv
    ac = c[:, None] * inv
    ang = jnp.concatenate([ar, ar, ac, ac], axis=-1)
    return jnp.cos(ang), jnp.sin(ang)


def rotate_half(u):
    u1, u2 = jnp.split(u, 2, axis=-1)
    return jnp.concatenate([-u2, u1], axis=-1)


def apply_axial_rope(x, cos, sin):
    xf = x.astype(jnp.float32)
    xr, xc = jnp.split(xf, 2, axis=-1)
    rot = jnp.concatenate([rotate_half(xr), rotate_half(xc)], axis=-1)
    return (xf * cos[None, :, None, :] + rot * sin[None, :, None, :]).astype(x.dtype)


def blocked_gqa_attention(q, k, v):
    B, S, H, Dh = q.shape
    G = H // N_KV_HEADS
    nblk = S // Q_BLOCK
    qb = q.reshape(B, nblk, Q_BLOCK, N_KV_HEADS, G, Dh).transpose(1, 0, 2, 3, 4, 5)
    scale = HEAD_DIM ** -0.5

    def one_block(qi):
        s = jnp.einsum("bqkgd,btkd->bkgqt", qi, k, preferred_element_type=jnp.float32) * scale
        p = jax.nn.softmax(s, axis=-1).astype(v.dtype)
        return jnp.einsum("bkgqt,btkd->bqkgd", p, v)

    o = lax.map(one_block, qb)
    return o.transpose(1, 0, 2, 3, 4, 5).reshape(B, S, H * Dh)


def centred_depthwise_conv(x, w, b):
    y = lax.conv_general_dilated(
        x, w[:, None, :], window_strides=(1,),
        padding=[(CONV_W // 2, CONV_W - 1 - CONV_W // 2)],
        dimension_numbers=("NWC", "WIO", "NWC"),
        feature_group_count=x.shape[-1])
    return y + b


def block_diag_linear(x, w, b):
    xb = x.reshape(x.shape[:-1] + (LRU_BLOCKS, LRU_BLOCK))
    y = jnp.einsum("bsnd,nde->bsne", xb, w)
    return y.reshape(x.shape) + b


def linear_scan(a, b, h0, reverse):
    if h0 is not None:
        edge = -1 if reverse else 0
        b = b.at[:, edge].add(a[:, edge] * h0)

    def combine(e1, e2):
        a1, b1 = e1
        a2, b2 = e2
        return a1 * a2, a2 * b1 + b2

    _, h = lax.associative_scan(combine, (a, b), axis=1, reverse=reverse)
    return h


def rglru_direction(x, wa, ba, wx, bx, lam, h0, reverse):
    xf = x.astype(jnp.float32)
    r = jax.nn.sigmoid(block_diag_linear(x, wa, ba).astype(jnp.float32))
    i = jax.nn.sigmoid(block_diag_linear(x, wx, bx).astype(jnp.float32))
    log_a = -LRU_C * r * jax.nn.softplus(-lam.astype(jnp.float32))
    a = jnp.exp(log_a)
    b = jnp.sqrt(-jnp.expm1(2.0 * log_a)) * (i * xf)
    h = linear_scan(a, b, None if h0 is None else h0.astype(jnp.float32), reverse)
    h_final = h[:, 0] if reverse else h[:, -1]
    return h, h_final


def bidirectional_rglru(x, wa, ba, wx, bx, lam, h0):
    hf, ff = rglru_direction(x, wa[0], ba[0], wx[0], bx[0], lam[0],
                             None if h0 is None else h0[:, 0], False)
    hb, fb = rglru_direction(x, wa[1], ba[1], wx[1], bx[1], lam[1],
                             None if h0 is None else h0[:, 1], True)
    return (hf + hb).astype(x.dtype), jnp.stack([ff, fb], axis=1).astype(x.dtype)


def parallel_mixer(h, lp, rope, ctx_k, ctx_v, h0):
    (_, _, _, _, w_in, w_out, q_norm, k_norm, conv_w, conv_b,
     lru_wa, lru_ba, lru_wx, lru_bx, lru_lambda) = lp
    B, S, _ = h.shape
    proj = h @ w_in
    q, k, v, xl, gl = jnp.split(
        proj, [ATTN_W, ATTN_W + KV_W, ATTN_W + 2 * KV_W, ATTN_W + 2 * KV_W + LRU_W], axis=-1)
    q = rms_norm(q.reshape(B, S, N_HEADS, HEAD_DIM), q_norm)
    k = rms_norm(k.reshape(B, S, N_KV_HEADS, HEAD_DIM), k_norm)
    v = v.reshape(B, S, N_KV_HEADS, HEAD_DIM)
    if rope is not None:
        q = apply_axial_rope(q, *rope)
        k_att = apply_axial_rope(k, *rope)
    else:
        k_att = k
    if ctx_k is not None:
        k_all = jnp.concatenate([k_att, ctx_k], axis=1)
        v_all = jnp.concatenate([v, ctx_v], axis=1)
    else:
        k_all, v_all = k_att, v
    attn_out = blocked_gqa_attention(q, k_all, v_all)
    xc = centred_depthwise_conv(xl, conv_w, conv_b)
    y_lru, h_final = bidirectional_rglru(xc, lru_wa, lru_ba, lru_wx, lru_bx, lru_lambda, h0)
    lru_out = y_lru * jax.nn.gelu(gl)
    out = jnp.concatenate([attn_out, lru_out], axis=-1) @ w_out
    return out, k, v, h_final


def trunk_layer(x, m, lp, rope, ctx_k, ctx_v, h0):
    norm_pre, norm_post, ffn_w_in, ffn_w_out = lp[0], lp[1], lp[2], lp[3]

    def pre(x, j):
        return rms_norm(x, norm_pre[j]) * (1 + m[:, :, 3 * j + 1]) + m[:, :, 3 * j]

    def post(x, out, j, res_w):
        return x + res_w * m[:, :, 3 * j + 2] * rms_norm(out, norm_post[j])

    x = post(x, swiglu(pre(x, 0), ffn_w_in[0], ffn_w_out[0]), 0, 0.5)
    mix, k, v, h_final = parallel_mixer(pre(x, 1), lp, rope, ctx_k, ctx_v, h0)
    x = post(x, mix, 1, 1.0)
    x = post(x, swiglu(pre(x, 2), ffn_w_in[1], ffn_w_out[1]), 2, 0.5)
    return x, k, v, h_final


def take_layer(l, *arrays):
    return tuple(a[l] for a in arrays)


def setup_inputs(seed: int = 0) -> dict:
    key = jax.random.key(seed)
    ks = jax.random.split(key, 24)
    f32 = jnp.float32

    def nrm(k, shape, scale):
        return jax.random.normal(k, shape, f32) * scale

    u = jax.random.uniform(ks[23], (DEPTH, 2, LRU_W), f32, 0.9, 0.999)
    a = u ** (1.0 / LRU_C)
    return {
        "x_prompt": nrm(ks[0], (BATCH, SEQ, D_MODEL), 1.0),
        "x_sample": nrm(ks[1], (DEC_BATCH, DEC_SEQ, D_MODEL), 1.0),
        "c": nrm(ks[2], (DEC_BATCH, D_MODEL), 1.0),
        "cache_k": nrm(ks[3], (DEC_BATCH, DEPTH, PAST_LEN, N_KV_HEADS, HEAD_DIM), 1.0),
        "cache_v": nrm(ks[4], (DEC_BATCH, DEPTH, PAST_LEN, N_KV_HEADS, HEAD_DIM), 1.0),
        "state_lru": nrm(ks[5], (DEC_BATCH, DEPTH, 2, LRU_W), 0.5),
        "c_ctx": nrm(ks[6], (D_MODEL,), 1.0),
        "w_mod": nrm(ks[7], (DEPTH, D_MODEL, 3 * N_SUB * D_MODEL), 0.5 * D_MODEL ** -0.5),
        "b_mod": nrm(ks[8], (DEPTH, 3 * N_SUB * D_MODEL), 0.02),
        "norm_pre": 1.0 + nrm(ks[9], (DEPTH, N_SUB, D_MODEL), 0.1),
        "norm_post": 1.0 + nrm(ks[10], (DEPTH, N_SUB, D_MODEL), 0.1),
        "ffn_w_in": nrm(ks[11], (DEPTH, 2, D_MODEL, 2 * FFN_DIM), D_MODEL ** -0.5),
        "ffn_w_out": nrm(ks[12], (DEPTH, 2, FFN_DIM, D_MODEL), FFN_DIM ** -0.5),
        "w_in": nrm(ks[13], (DEPTH, D_MODEL, IN_COLS), D_MODEL ** -0.5),
        "w_out": nrm(ks[14], (DEPTH, MIX_W, D_MODEL), MIX_W ** -0.5),
        "q_norm": 1.0 + nrm(ks[15], (DEPTH, HEAD_DIM), 0.1),
        "k_norm": 1.0 + nrm(ks[16], (DEPTH, HEAD_DIM), 0.1),
        "conv_w": nrm(ks[17], (DEPTH, CONV_W, LRU_W), CONV_W ** -0.5),
        "conv_b": nrm(ks[18], (DEPTH, LRU_W), 0.02),
        "lru_wa": nrm(ks[19], (DEPTH, 2, LRU_BLOCKS, LRU_BLOCK, LRU_BLOCK), LRU_BLOCK ** -0.5),
        "lru_ba": nrm(ks[20], (DEPTH, 2, LRU_W), 0.02),
        "lru_wx": nrm(ks[21], (DEPTH, 2, LRU_BLOCKS, LRU_BLOCK, LRU_BLOCK), LRU_BLOCK ** -0.5),
        "lru_bx": nrm(ks[22], (DEPTH, 2, LRU_W), 0.02),
        "lru_lambda": jnp.log(a) - jnp.log1p(-a),
    }


def reference(x_prompt, x_sample, c, cache_k, cache_v, state_lru, c_ctx, w_mod, b_mod,
              norm_pre, norm_post, ffn_w_in, ffn_w_out, w_in, w_out, q_norm, k_norm,
              conv_w, conv_b, lru_wa, lru_ba, lru_wx, lru_bx, lru_lambda):
    layer_arrays = (norm_pre, norm_post, ffn_w_in, ffn_w_out, w_in, w_out, q_norm, k_norm,
                    conv_w, conv_b, lru_wa, lru_ba, lru_wx, lru_bx, lru_lambda)
    y_prompt = x_prompt
    ks, vs, hs = [], [], []
    for l in range(DEPTH):
        lp = take_layer(l, *layer_arrays)
        m_ctx = modulation(c_ctx, w_mod[l], b_mod[l])
        y_prompt, k_l, v_l, h_l = trunk_layer(y_prompt, m_ctx, lp, None, None, None, None)
        ks.append(k_l)
        vs.append(v_l)
        hs.append(h_l)
    new_cache_k = jnp.stack(ks, axis=1)
    new_cache_v = jnp.stack(vs, axis=1)
    new_state_lru = jnp.stack(hs, axis=1)
    rope = axial_rope_tables(x_sample.shape[1])
    y_sample = x_sample
    for l in range(DEPTH):
        lp = take_layer(l, *layer_arrays)
        m_lat = modulation(c, w_mod[l], b_mod[l])
        y_sample, _, _, _ = trunk_layer(y_sample, m_lat, lp, rope,
                                        cache_k[:, l], cache_v[:, l], state_lru[:, l])
    return (y_prompt, y_sample, new_cache_k, new_cache_v, new_state_lru)
```

```cpp
#include <hip/hip_runtime.h>
#include <hip/hip_bf16.h>
#include <cstdio>
#include <cstdint>
#include <cmath>

#ifndef DBG_CHECK
#define DBG_CHECK 0
#endif

constexpr int DM = 1024, NCTX = 32 * 256, NLAT = 8 * 4096, MTOK = NCTX + NLAT;
constexpr int FFN = 2816, INC = 1792, NMOD = 9 * DM;
constexpr int SEQ_C = 256, SEQ_L = 4096, PAST = 512, TKL = SEQ_L + PAST;
constexpr float EPSN = 1e-6f;

constexpr size_t MiB = 1u << 20;
constexpr size_t WS_CTL = 0, CTL_ZERO_BYTES = 1 * MiB;
constexpr size_t WS_MOD = 1 * MiB;
constexpr size_t WS_ROPE = 1 * MiB + 384 * 1024;
constexpr size_t WS_DBG = 1 * MiB + 448 * 1024;
constexpr size_t WS_WUP1 = 2 * MiB, WS_WUP2 = 13 * MiB;
constexpr size_t WS_WDN1 = 24 * MiB, WS_WDN2 = 30 * MiB;
constexpr size_t WS_WIN = 36 * MiB, WS_WOUT = 40 * MiB;
constexpr size_t WS_H = 44 * MiB;
constexpr size_t WS_OUTF = 124 * MiB;
constexpr size_t WS_ACT = 284 * MiB;
constexpr size_t WS_Q = 284 * MiB, WS_XL = 324 * MiB, WS_GL = 364 * MiB, WS_HF = 404 * MiB;
constexpr size_t WS_KL = 484 * MiB, WS_VL = 493 * MiB, WS_KC = 502 * MiB, WS_VC = 504 * MiB;
constexpr size_t WS_END = 506 * MiB;
static_assert(WS_ACT + (size_t)MTOK * FFN * 2 <= WS_END && WS_HF + (size_t)MTOK * 512 * 4 <= WS_KL && WS_KL + (size_t)8 * TKL * 128 * 2 <= WS_VL && WS_VL + (size_t)8 * TKL * 128 * 2 <= WS_KC && WS_VC + (size_t)NCTX * 128 * 2 <= WS_END, "d_ws map");
static_assert(WS_OUTF + (size_t)MTOK * DM * 4 <= WS_ACT && WS_H + (size_t)MTOK * DM * 2 <= WS_OUTF, "d_ws map");

namespace pg8 {
#define PG8_LAS __attribute__((address_space(3)))
typedef unsigned short bf16_t;
typedef short bf16x8 __attribute__((ext_vector_type(8)));
typedef float f32x4 __attribute__((ext_vector_type(4)));
typedef unsigned u32x4 __attribute__((ext_vector_type(4)));
typedef unsigned u32x2 __attribute__((ext_vector_type(2)));
constexpr int BM = 256, BK = 64, HALF = 128, HTB = HALF * BK * 2  , STAGE_BYTES = 8 * HTB, NXCD = 8, WGM = 8;

__host__ __device__ __forceinline__ int lds_byte(int r, int c) { const int st = (r >> 4) * 2 + (c >> 5), rr = r & 15, cc = c & 31, ob = rr * 64 + cc * 2; return st * 1024 + (ob ^ (((ob >> 9) & 1) << 5)); }
__host__ __device__ __forceinline__ void stage_rc(int b, int& R, int& C) { const int st = b / 1024, sb = b % 1024, swz = sb ^ (((sb >> 9) & 1) << 5); R = (st >> 1) * 16 + swz / 64; C = (st & 1) * 32 + (swz % 64) / 2; }
__host__ __device__ __forceinline__ int perm32(int rho) { const int n = rho >> 4, i = rho & 15; return 8 * (i >> 2) + 4 * n + (i & 3); }

struct Unit { int pm, pn; };
struct Gemm { const bf16_t* A; const bf16_t* Bt; int M, N, K; };

struct StaticOrder {
    int nM, nN, nwg, G, c;
    __host__ __device__ void init(int M, int N, int G_, int c_) { nM = M / BM; nN = N / BM; nwg = nM * nN; G = G_; c = c_; }
    __host__ __device__ bool next(int i, Unit& u) const {
        const long L = (long)i * G + c; if (L >= nwg) return false;
        int wgid = (int)L; { const int q = nwg / NXCD, r = nwg % NXCD, xcd = wgid % NXCD, off = wgid / NXCD; wgid = (xcd < r ? xcd * (q + 1) : r * (q + 1) + (xcd - r) * q) + off; }
        const int nig = WGM * nN, gid = wgid / nig, fm = gid * WGM, gsz = (nM - fm) < WGM ? (nM - fm) : WGM;
        u.pm = fm + ((wgid % nig) % gsz); u.pn = (wgid % nig) / gsz; return true;
    }
    __device__ __forceinline__ void a_ready(const Unit&) const {}
    __device__ __forceinline__ void done(const Unit&) const {}
};

__device__ __forceinline__ unsigned cvt_pk_bf16(float lo, float hi) { unsigned r; asm volatile("v_cvt_pk_bf16_f32 %0, %1, %2" : "=v"(r) : "v"(lo), "v"(hi)); return r; }
__device__ __forceinline__ float silu_f(float g) { return g * __builtin_amdgcn_rcpf(1.0f + __expf(-g)); }
__device__ __forceinline__ float gelu_tanh_f(float x) { const float z = 0.7978845608028654f * (x + 0.044715f * x * x * x); return x * __builtin_amdgcn_rcpf(1.0f + __expf(-2.0f * z)); }

struct EpiSwiglu {
    static constexpr bool PERM = true, AFTER_DRAIN = false;
    bf16_t* O;
    __device__ __forceinline__ void operator()(const f32x4 (&acc)[2][2][4][2], const Unit& u, int wr, int wc, int fr, int fq) const {
        const int row0 = u.pm * BM + wr * 64 + fr, col0 = u.pn * 128 + wc * 32 + 8 * fq;
#pragma unroll
        for (int ai = 0; ai < 2; ++ai)
#pragma unroll
            for (int m = 0; m < 4; ++m) {
                bf16_t* rowp = O + (size_t)(row0 + ai * HALF + m * 16) * FFN + col0;
                const f32x4 g0 = acc[ai][0][m][0], g1 = acc[ai][0][m][1], u0 = acc[ai][1][m][0], u1 = acc[ai][1][m][1];
                float r[8];
#pragma unroll
                for (int j = 0; j < 4; ++j) { r[j] = silu_f(g0[j]) * u0[j]; r[4 + j] = silu_f(g1[j]) * u1[j]; }
                u32x4 w; w.x = cvt_pk_bf16(r[0], r[1]); w.y = cvt_pk_bf16(r[2], r[3]); w.z = cvt_pk_bf16(r[4], r[5]); w.w = cvt_pk_bf16(r[6], r[7]);
                *(u32x4*)rowp = w;
            }
    }
};
struct EpiF32 {
    static constexpr bool PERM = false, AFTER_DRAIN = false;
    float* O; int ldc;
    __device__ __forceinline__ void operator()(const f32x4 (&acc)[2][2][4][2], const Unit& u, int wr, int wc, int fr, int fq) const {
        const int row0 = u.pm * BM + wr * 64 + fr, col0 = u.pn * BM + wc * 32 + 4 * fq;
#pragma unroll
        for (int ai = 0; ai < 2; ++ai)
#pragma unroll
            for (int m = 0; m < 4; ++m) {
                float* rowp = O + (size_t)(row0 + ai * HALF + m * 16) * ldc + col0;
#pragma unroll
                for (int bj = 0; bj < 2; ++bj)
#pragma unroll
                    for (int n = 0; n < 2; ++n) *(f32x4*)(rowp + bj * HALF + n * 16) = acc[ai][bj][m][n];
            }
    }
};
struct EpiInProj {
    static constexpr bool PERM = false, AFTER_DRAIN = false;
    unsigned char* ws; float* outb; const float *qn, *kn;
    static constexpr float qscale = 0.125f * 1.4426950408889634f;
    __device__ __forceinline__ void operator()(const f32x4 (&acc)[2][2][4][2], const Unit& u, int wr, int wc, int fr_, int fq_) const {
        int fr = fr_, fq = fq_; asm volatile("" : "+v"(fr), "+v"(fq));
        const int pn = u.pn; const bool lat = u.pm >= (NCTX / BM);
        bf16_t* const Q = (bf16_t*)(ws + WS_Q); bf16_t* const Kc = (bf16_t*)(ws + WS_KC); bf16_t* const Vc = (bf16_t*)(ws + WS_VC); bf16_t* const Kl = (bf16_t*)(ws + WS_KL); bf16_t* const Vl = (bf16_t*)(ws + WS_VL);
        bf16_t* const XL = (bf16_t*)(ws + WS_XL); bf16_t* const GL = (bf16_t*)(ws + WS_GL); const float* const rope = (const float*)(ws + WS_ROPE);
        float* const ock = outb + (size_t)MTOK * DM; float* const ocv = ock + (size_t)NCTX * 128;
        const int rowb = u.pm * BM + wr * 64 + fr;
        if (pn <= 2) {
            const bool isq = pn < 2, isv = (pn == 2) && (wc >= 2);
            const float* gn = isq ? qn : kn;
            const int head = isq ? (4 * pn + wc) : (wc & 1);
#pragma unroll
            for (int ai = 0; ai < 2; ++ai)
#pragma unroll
                for (int m = 0; m < 4; ++m) {
                    const int R = rowb + ai * HALF + m * 16;
                    f32x4 v[2][2];
#pragma unroll
                    for (int bj = 0; bj < 2; ++bj)
#pragma unroll
                        for (int n = 0; n < 2; ++n) v[bj][n] = acc[ai][bj][m][n];
                    if (!isv) {
                        float ss = 0.f;
#pragma unroll
                        for (int bj = 0; bj < 2; ++bj)
#pragma unroll
                            for (int n = 0; n < 2; ++n) ss += (v[bj][n][0] * v[bj][n][0] + v[bj][n][1] * v[bj][n][1]) + (v[bj][n][2] * v[bj][n][2] + v[bj][n][3] * v[bj][n][3]);
                        ss += __shfl_xor(ss, 16); ss += __shfl_xor(ss, 32);
                        const float rstd = 1.0f / sqrtf(ss * (1.0f / 64.0f) + EPSN);
#pragma unroll
                        for (int bj = 0; bj < 2; ++bj)
#pragma unroll
                            for (int n = 0; n < 2; ++n) v[bj][n] = v[bj][n] * rstd * *(const f32x4*)(gn + bj * 32 + 16 * n + 4 * fq);
                    }
                    if (!lat) {
                        if (!isq) {
                            float* od = (isv ? ocv : ock) + (size_t)R * 128 + head * 64; bf16_t* bd = (isv ? Vc : Kc) + (size_t)R * 128 + head * 64;
#pragma unroll
                            for (int bj = 0; bj < 2; ++bj)
#pragma unroll
                                for (int n = 0; n < 2; ++n) { const int d = bj * 32 + 16 * n + 4 * fq; *(f32x4*)(od + d) = v[bj][n];
                                    u32x2 w; w.x = cvt_pk_bf16(v[bj][n][0], v[bj][n][1]); w.y = cvt_pk_bf16(v[bj][n][2], v[bj][n][3]); *(u32x2*)(bd + d) = w; }
                        } else {
                            bf16_t* bd = Q + (size_t)R * 512 + head * 64;
#pragma unroll
                            for (int bj = 0; bj < 2; ++bj)
#pragma unroll
                                for (int n = 0; n < 2; ++n) { const int d = bj * 32 + 16 * n + 4 * fq; const f32x4 o = v[bj][n] * qscale;
                                    u32x2 w; w.x = cvt_pk_bf16(o[0], o[1]); w.y = cvt_pk_bf16(o[2], o[3]); *(u32x2*)(bd + d) = w; }
                        }
                    } else {
                        const int Rl = R - NCTX, b = Rl >> 12, t = Rl & (SEQ_L - 1);
                        if (!isv) {
#pragma unroll
                            for (int bj = 0; bj < 2; ++bj) {
                                const int pos = bj == 0 ? (t >> 6) : (t & 63);
                                const f32x4 t0 = *(const f32x4*)(rope + pos * 32 + 8 * fq), t1 = *(const f32x4*)(rope + pos * 32 + 8 * fq + 4);
                                const float cs[4] = {t0[0], t0[2], t1[0], t1[2]}, sn[4] = {t0[1], t0[3], t1[1], t1[3]};
#pragma unroll
                                for (int j = 0; j < 4; ++j) { const float x0 = v[bj][0][j], x1 = v[bj][1][j]; v[bj][0][j] = x0 * cs[j] - x1 * sn[j]; v[bj][1][j] = x1 * cs[j] + x0 * sn[j]; }
                            }
                        }
                        bf16_t* bd; float sc = 1.0f;
                        if (isq) { bd = Q + (size_t)R * 512 + head * 64; sc = qscale; }
                        else bd = (isv ? Vl : Kl) + ((size_t)b * TKL + t) * 128 + head * 64;
#pragma unroll
                        for (int bj = 0; bj < 2; ++bj)
#pragma unroll
                            for (int n = 0; n < 2; ++n) { const int d = bj * 32 + 16 * n + 4 * fq; const f32x4 o = v[bj][n] * sc;
                                u32x2 w; w.x = cvt_pk_bf16(o[0], o[1]); w.y = cvt_pk_bf16(o[2], o[3]); *(u32x2*)(bd + d) = w; }
                    }
                    asm volatile("" ::: "memory");
                }
        } else {
            const bool isg = pn >= 5; bf16_t* dst = isg ? GL : XL; const int colb = (isg ? pn - 5 : pn - 3) * BM + wc * 32 + 8 * fq;
#pragma unroll
            for (int ai = 0; ai < 2; ++ai)
#pragma unroll
                for (int m = 0; m < 4; ++m) {
                    const int R = rowb + ai * HALF + m * 16;
#pragma unroll
                    for (int bj = 0; bj < 2; ++bj) {
                        f32x4 a = acc[ai][bj][m][0], c = acc[ai][bj][m][1];
                        if (isg) {
#pragma unroll
                            for (int j = 0; j < 4; ++j) { a[j] = gelu_tanh_f(a[j]); c[j] = gelu_tanh_f(c[j]); }
                        }
                        u32x4 w; w.x = cvt_pk_bf16(a[0], a[1]); w.y = cvt_pk_bf16(a[2], a[3]); w.z = cvt_pk_bf16(c[0], c[1]); w.w = cvt_pk_bf16(c[2], c[3]);
                        *(u32x4*)(dst + (size_t)R * 512 + colb + bj * HALF) = w;
                    }
                }
        }
    }
};

template <class Epi, class Sched, bool ALIGN_EPI = false, bool SP2 = false>
__device__ __forceinline__ void gemm_phase(PG8_LAS unsigned char* lds, const Gemm g, const Sched& S, const Epi& E) {
    int tid_l = threadIdx.x; asm volatile("" : "+v"(tid_l));
    const int tid = tid_l, wid = __builtin_amdgcn_readfirstlane(tid >> 6), lane = tid & 63, wr = wid >> 2, wc = wid & 3, fr = lane & 15, fq = lane >> 4;
    const int K = g.K, nt = K / BK;
    unsigned voffA[2], voffB[2];
#pragma unroll
    for (int i = 0; i < 2; ++i) { int R, C; stage_rc(tid * 16 + i * 8192, R, C); const int Rb = Epi::PERM ? ((R & ~31) + perm32(R & 31)) : R;
        voffA[i] = (unsigned)(R * K + C) * 2u; voffB[i] = (unsigned)(Rb * K + C) * 2u; }
    const size_t kstep = (size_t)(BK * 2);
    const size_t hstep = (size_t)HALF * K * 2;
    const size_t tstep = 2 * hstep;
    const unsigned ldsw = (unsigned)wid * 1024u;
    const int aoff = lds_byte(wr * 64 + fr, fq * 8), boff = lds_byte(wc * 32 + fr, fq * 8);
#define PG8_SA(b, h) (((b) * 2 + (h)) * HTB)
#define PG8_SB(b, h) ((4 + (b) * 2 + (h)) * HTB)
#define PG8_STAGE(bufoff, gbase, voff) do { _Pragma("unroll") for (int _i = 0; _i < 2; ++_i) \
        __builtin_amdgcn_global_load_lds((const unsigned*)((const char*)(gbase) + (voff)[_i]), (PG8_LAS unsigned*)(lds + (bufoff) + ldsw + _i * 8192), 16, 0, 0); } while (0)
#define PG8_LDA(dst, b, h) do { _Pragma("unroll") for (int m = 0; m < 4; ++m) _Pragma("unroll") for (int k = 0; k < 2; ++k) dst[m][k] = *(const PG8_LAS bf16x8*)(lds + PG8_SA(b, h) + aoff + m * 2048 + k * 1024); } while (0)
#define PG8_LDB(dst, b, h) do { _Pragma("unroll") for (int n = 0; n < 2; ++n) _Pragma("unroll") for (int k = 0; k < 2; ++k) dst[n][k] = *(const PG8_LAS bf16x8*)(lds + PG8_SB(b, h) + boff + n * 2048 + k * 1024); } while (0)
#define PG8_MMA(ai, bj, At, Bt) do { __builtin_amdgcn_s_setprio(1); _Pragma("unroll") for (int m = 0; m < 4; ++m) _Pragma("unroll") for (int n = 0; n < 2; ++n) _Pragma("unroll") for (int k = 0; k < 2; ++k) \
        acc[ai][bj][m][n] = __builtin_amdgcn_mfma_f32_16x16x32_bf16(Bt[n][k], At[m][k], acc[ai][bj][m][n], 0, 0, 0); __builtin_amdgcn_s_setprio(0); } while (0)
#define PG8_WAIT_V(n) asm volatile("s_waitcnt vmcnt(" #n ")" ::: "memory")
#define PG8_WAIT_L(n) asm volatile("s_waitcnt lgkmcnt(" #n ")" ::: "memory")
#define PG8_BAR __builtin_amdgcn_s_barrier()
#define PG8_SCHED __builtin_amdgcn_sched_barrier(0)
    Unit cur, nxt; int ui = 0;
    if (!S.next(0, cur)) return;
    f32x4 acc[2][2][4][2];
#pragma unroll
    for (int a = 0; a < 2; ++a)
#pragma unroll
        for (int b = 0; b < 2; ++b)
#pragma unroll
            for (int m = 0; m < 4; ++m)
#pragma unroll
                for (int n = 0; n < 2; ++n) acc[a][b][m][n] = (f32x4){0.f, 0.f, 0.f, 0.f};
    bf16x8 At[4][2], B0[2][2], B1[2][2];
    const char* cA = (const char*)g.A + (size_t)cur.pm * tstep; const char* cB = (const char*)g.Bt + (size_t)cur.pn * tstep;
    S.a_ready(cur);
    if constexpr (SP2) {
        PG8_STAGE(PG8_SB(0, 0), cB, voffB); PG8_STAGE(PG8_SB(0, 1), cB + hstep, voffB); PG8_STAGE(PG8_SA(0, 0), cA, voffA); PG8_STAGE(PG8_SA(0, 1), cA + hstep, voffA);
        if (wr == 1) PG8_BAR;
        PG8_WAIT_V(2); PG8_BAR;
        PG8_STAGE(PG8_SB(1, 0), cB + kstep, voffB); PG8_STAGE(PG8_SA(1, 0), cA + kstep, voffA); PG8_STAGE(PG8_SB(1, 1), cB + hstep + kstep, voffB);
        PG8_WAIT_V(6); PG8_BAR;
    } else {
        PG8_STAGE(PG8_SB(0, 0), cB, voffB); PG8_STAGE(PG8_SA(0, 0), cA, voffA); PG8_STAGE(PG8_SB(0, 1), cB + hstep, voffB); PG8_STAGE(PG8_SA(0, 1), cA + hstep, voffA);
        if (wr == 1) PG8_BAR;
        PG8_WAIT_V(4); PG8_BAR;
        PG8_STAGE(PG8_SB(1, 0), cB + kstep, voffB); PG8_STAGE(PG8_SA(1, 0), cA + kstep, voffA); PG8_STAGE(PG8_SB(1, 1), cB + hstep + kstep, voffB);
        PG8_WAIT_V(6); PG8_BAR;
    }
    for (;;) {
        const bool has_next = S.next(ui + 1, nxt);
        const char* nA = has_next ? (const char*)g.A + (size_t)nxt.pm * tstep : cA; const char* nB = has_next ? (const char*)g.Bt + (size_t)nxt.pn * tstep : cB;
        for (int t = 0; t < nt; t += 2) {
            const bool last = (t == nt - 2);
            const char* a1 = cA + (size_t)(t + 1) * kstep;
            const char* a2 = last ? nA : cA + (size_t)(t + 2) * kstep; const char* b2 = last ? nB : cB + (size_t)(t + 2) * kstep;
            const char* a3 = a2 + kstep; const char* b3 = b2 + kstep;
            if (last && has_next) S.a_ready(nxt);
            if constexpr (SP2) {
            PG8_LDB(B0, 0, 0); PG8_LDB(B1, 0, 1); PG8_SCHED; PG8_LDA(At, 0, 0); PG8_STAGE(PG8_SA(1, 1), a1 + hstep, voffA);
            PG8_WAIT_V(8); PG8_WAIT_L(0); PG8_BAR; PG8_MMA(0, 0, At, B0); PG8_MMA(0, 1, At, B1); PG8_BAR; PG8_SCHED;
            PG8_LDA(At, 0, 1); PG8_STAGE(PG8_SB(0, 0), b2, voffB); PG8_STAGE(PG8_SB(0, 1), b2 + hstep, voffB); PG8_STAGE(PG8_SA(0, 0), a2, voffA);
            PG8_WAIT_V(8); PG8_WAIT_L(0); PG8_BAR; PG8_MMA(1, 0, At, B0); PG8_MMA(1, 1, At, B1); PG8_BAR; PG8_SCHED;
            PG8_LDB(B0, 1, 0); PG8_LDB(B1, 1, 1); PG8_SCHED; PG8_LDA(At, 1, 0); PG8_STAGE(PG8_SA(0, 1), a2 + hstep, voffA);
            PG8_WAIT_V(8); PG8_WAIT_L(0); PG8_BAR; PG8_MMA(0, 0, At, B0); PG8_MMA(0, 1, At, B1); PG8_BAR; PG8_SCHED;
            PG8_LDA(At, 1, 1); PG8_STAGE(PG8_SB(1, 0), b3, voffB); PG8_STAGE(PG8_SB(1, 1), b3 + hstep, voffB); PG8_STAGE(PG8_SA(1, 0), a3, voffA);
            PG8_WAIT_V(8); PG8_WAIT_L(0); PG8_BAR; PG8_MMA(1, 0, At, B0); PG8_MMA(1, 1, At, B1); PG8_BAR; PG8_SCHED;
            } else {
            PG8_LDB(B0, 0, 0); PG8_SCHED; PG8_LDA(At, 0, 0); PG8_STAGE(PG8_SA(1, 1), a1 + hstep, voffA);
            PG8_WAIT_L(8); PG8_BAR; PG8_WAIT_L(0); PG8_MMA(0, 0, At, B0); PG8_BAR; PG8_SCHED;
            PG8_LDB(B1, 0, 1); PG8_STAGE(PG8_SB(0, 0), b2, voffB);
            PG8_BAR; PG8_WAIT_L(0); PG8_MMA(0, 1, At, B1); PG8_BAR;
            PG8_LDA(At, 0, 1); PG8_STAGE(PG8_SA(0, 0), a2, voffA);
            PG8_BAR; PG8_WAIT_L(0); PG8_MMA(1, 0, At, B0); PG8_BAR; PG8_SCHED;
            PG8_STAGE(PG8_SB(0, 1), b2 + hstep, voffB);
            PG8_WAIT_V(6); PG8_BAR; PG8_MMA(1, 1, At, B1); PG8_BAR;
            PG8_LDB(B0, 1, 0); PG8_SCHED; PG8_LDA(At, 1, 0); PG8_STAGE(PG8_SA(0, 1), a2 + hstep, voffA);
            PG8_WAIT_L(8); PG8_BAR; PG8_WAIT_L(0); PG8_MMA(0, 0, At, B0); PG8_BAR; PG8_SCHED;
            PG8_LDB(B1, 1, 1); PG8_STAGE(PG8_SB(1, 0), b3, voffB);
            PG8_BAR; PG8_WAIT_L(0); PG8_MMA(0, 1, At, B1); PG8_BAR;
            PG8_LDA(At, 1, 1); PG8_STAGE(PG8_SA(1, 0), a3, voffA);
            PG8_BAR; PG8_WAIT_L(0); PG8_MMA(1, 0, At, B0); PG8_BAR; PG8_SCHED;
            PG8_STAGE(PG8_SB(1, 1), b3 + hstep, voffB);
            PG8_WAIT_V(6); PG8_BAR; PG8_MMA(1, 1, At, B1); PG8_BAR;
            }
        }
        if constexpr (ALIGN_EPI) { if (wr == 0) PG8_BAR; }
        if constexpr (!Epi::AFTER_DRAIN) { E(acc, cur, wr, wc, fr, fq); S.done(cur); }
        if (!has_next) break;
#pragma unroll
        for (int a = 0; a < 2; ++a)
#pragma unroll
            for (int b = 0; b < 2; ++b)
#pragma unroll
                for (int m = 0; m < 4; ++m)
#pragma unroll
                    for (int n = 0; n < 2; ++n) acc[a][b][m][n] = (f32x4){0.f, 0.f, 0.f, 0.f};
        cur = nxt; cA = nA; cB = nB; ++ui;
        if constexpr (ALIGN_EPI) { if (wr == 1) PG8_BAR; }
    }
    PG8_WAIT_V(0);
    if constexpr (!ALIGN_EPI) { if (wr == 0) PG8_BAR; }
    PG8_BAR;
    if constexpr (Epi::AFTER_DRAIN) { E.fused(acc, cur, wr, wc, fr, fq, lds, wid, lane); S.done(cur); }
#undef PG8_SA
#undef PG8_SB
#undef PG8_STAGE
#undef PG8_LDA
#undef PG8_LDB
#undef PG8_MMA
#undef PG8_WAIT_V
#undef PG8_WAIT_L
#undef PG8_BAR
#undef PG8_SCHED
}
}
#include <hip/hip_bf16.h>
#include <cmath>
namespace attn_body {
using bf16=__hip_bfloat16;
using bf16x8=__attribute__((ext_vector_type(8)))short;
using s16x4=__attribute__((ext_vector_type(4)))short;
using f32x16=__attribute__((ext_vector_type(16)))float;
using u32x4=__attribute__((ext_vector_type(4)))unsigned;
constexpr int D=64;
constexpr int NW=8,QBLK=32,QB=QBLK*NW,KVBLK=64;
constexpr int ATTN_UNIT_ROWS=QB;
__device__ __forceinline__ int crow(int r,int hi){return (r&3)+8*(r>>2)+4*hi;}
#define SBAR() __builtin_amdgcn_sched_barrier(0)
constexpr int NSLOT=3, SLOTB=8192;
constexpr int LDS_K=0, LDS_V=NSLOT*SLOTB, LDS_WS=2*NSLOT*SLOTB, LDS_OST=LDS_WS+NW*64*4, LDS_BYTES=LDS_OST+NW*4096;
constexpr float C2=0.125f*1.4426950408889634f;
__device__ __forceinline__ void glds16(const void*gsrc,unsigned lds_dst){unsigned keep;
  asm volatile("s_mov_b32 %0, m0\n\ts_mov_b32 m0, %2\n\ts_nop 0\n\tglobal_load_lds_dwordx4 %1, off\n\ts_mov_b32 m0, %0":"=&s"(keep):"v"(gsrc),"s"(lds_dst):"memory");}
__device__ __forceinline__ float max3f(float a,float b,float c){float r;asm("v_max3_f32 %0, %1, %2, %3":"=v"(r):"v"(a),"v"(b),"v"(c));return r;}
__device__ __forceinline__ float max2f(float a,float b){float r;asm("v_max_f32_e32 %0, %1, %2":"=v"(r):"v"(a),"v"(b));return r;}
__device__ __forceinline__ float fadd_s(float a,float b){float r;asm("v_add_f32_e32 %0, %1, %2":"=v"(r):"v"(a),"v"(b));return r;}
__device__ __forceinline__ float fsub_s(float a,float b){float r;asm("v_sub_f32_e32 %0, %1, %2":"=v"(r):"v"(a),"v"(b));return r;}
typedef float f32x2_t __attribute__((ext_vector_type(2))); typedef __bf16 bf16x2_t __attribute__((ext_vector_type(2)));
__device__ __forceinline__ unsigned cvtpk_s(float lo,float hi){f32x2_t v={lo,hi};bf16x2_t b=__builtin_convertvector(v,bf16x2_t);return __builtin_bit_cast(unsigned,b);}
#define WAIT_BAR(N) asm volatile("s_waitcnt vmcnt(" #N ") lgkmcnt(0)\n\ts_barrier":::"memory")

__device__ __forceinline__ void qkt(f32x16&p0,f32x16&p1,const char*Kslot,const bf16x8*qr,const f32x16&negm,int r32,int hi){
  const char*kb=Kslot+hi*1024+r32*16;
  #pragma unroll
  for(int d0=0;d0<4;++d0){
    const bf16x8 b0=*reinterpret_cast<const bf16x8*>(kb+d0*2048);
    const bf16x8 b1=*reinterpret_cast<const bf16x8*>(kb+d0*2048+512);
    if(d0==0){p0=__builtin_amdgcn_mfma_f32_32x32x16_bf16(b0,qr[0],negm,0,0,0);p1=__builtin_amdgcn_mfma_f32_32x32x16_bf16(b1,qr[0],negm,0,0,0);}
    else{p0=__builtin_amdgcn_mfma_f32_32x32x16_bf16(b0,qr[d0],p0,0,0,0);p1=__builtin_amdgcn_mfma_f32_32x32x16_bf16(b1,qr[d0],p1,0,0,0);}}
}
typedef __attribute__((address_space(3))) const char* lds_cptr;
typedef short v4i16_t __attribute__((ext_vector_type(4)));
__device__ __forceinline__ void kload8(bf16x8*kf,lds_cptr kp){
  kf[0]=*(const __attribute__((address_space(3))) bf16x8*)(kp);      kf[1]=*(const __attribute__((address_space(3))) bf16x8*)(kp+512);
  kf[2]=*(const __attribute__((address_space(3))) bf16x8*)(kp+2048); kf[3]=*(const __attribute__((address_space(3))) bf16x8*)(kp+2560);
  kf[4]=*(const __attribute__((address_space(3))) bf16x8*)(kp+4096); kf[5]=*(const __attribute__((address_space(3))) bf16x8*)(kp+4608);
  kf[6]=*(const __attribute__((address_space(3))) bf16x8*)(kp+6144); kf[7]=*(const __attribute__((address_space(3))) bf16x8*)(kp+6656);
}
__device__ __forceinline__ void kload2(bf16x8*kf,lds_cptr kp,int j){ kf[2*j]=*(const __attribute__((address_space(3))) bf16x8*)(kp+j*2048); kf[2*j+1]=*(const __attribute__((address_space(3))) bf16x8*)(kp+j*2048+512); }
__device__ __forceinline__ s16x4 vtr(lds_cptr p){ return __builtin_bit_cast(s16x4,__builtin_amdgcn_ds_read_tr16_b64_v4i16((__attribute__((address_space(3))) v4i16_t*)p)); }
__device__ __forceinline__ float rowmax(const f32x16&p0,const f32x16&p1){
  float a=max3f(p0[0],p0[1],p1[0]),b=max3f(p0[2],p0[3],p1[1]);a=max3f(a,p1[2],p1[3]);
  #pragma unroll
  for(int r=4;r<16;r+=4){a=max3f(a,p0[r],p0[r+1]);b=max3f(b,p0[r+2],p0[r+3]);a=max3f(a,p1[r],p1[r+1]);b=max3f(b,p1[r+2],p1[r+3]);}
  const float m=max2f(a,b);
  auto rr=__builtin_amdgcn_permlane32_swap(__float_as_uint(m),__float_as_uint(m),false,false);
  return max2f(__uint_as_float(rr[0]),__uint_as_float(rr[1]));
}
__device__ __forceinline__ void pv(f32x16*o,int vb,bf16x8 pa0,bf16x8 pa1,bf16x8 pa2,bf16x8 pa3){
  #pragma unroll
  for(int d0=0;d0<2;++d0){s16x4 lo[4],hi[4];
    #pragma unroll
    for(int ks=0;ks<4;++ks){
      asm volatile("ds_read_b64_tr_b16 %0,%1 offset:%c2":"=&v"(lo[ks]):"v"(vb),"i"(d0*4096+ks*1024):"memory");
      asm volatile("ds_read_b64_tr_b16 %0,%1 offset:%c2":"=&v"(hi[ks]):"v"(vb),"i"(d0*4096+ks*1024+512):"memory");}
    asm volatile("s_waitcnt lgkmcnt(0)":::"memory");SBAR();
    #define PK(k) (bf16x8){lo[k][0],lo[k][1],lo[k][2],lo[k][3],hi[k][0],hi[k][1],hi[k][2],hi[k][3]}
    o[d0]=__builtin_amdgcn_mfma_f32_32x32x16_bf16(pa0,PK(0),o[d0],0,0,0);
    o[d0]=__builtin_amdgcn_mfma_f32_32x32x16_bf16(pa1,PK(1),o[d0],0,0,0);
    o[d0]=__builtin_amdgcn_mfma_f32_32x32x16_bf16(pa2,PK(2),o[d0],0,0,0);
    o[d0]=__builtin_amdgcn_mfma_f32_32x32x16_bf16(pa3,PK(3),o[d0],0,0,0);
    #undef PK
  }
}

#ifndef ATTN_STORE16
#define ATTN_STORE16(p,v) (*(u32x4*)(p)=(v))
#endif
template<int THRL,int QP,int KP,int OP> __device__ __forceinline__ void attn_unit(const bf16*Qu,const bf16*__restrict__ Kh,const bf16*__restrict__ Vh,int NT,bf16*Ou,char*shm){
  int tid_l=threadIdx.x; asm volatile("":"+v"(tid_l));
  const int tid=tid_l,lane=tid&63,r32=lane&31,hi=lane>>5; const int wid=__builtin_amdgcn_readfirstlane(tid>>6);
  const bf16*Qw=Qu+(long)(wid*QBLK)*QP;
  const unsigned lds0=(unsigned)(uintptr_t)shm;
  float*wsf=(float*)(shm+LDS_WS)+wid*64;
  const bf16*ksrc=Kh+(long)lane*KP+wid*8;
  const bf16*vsrc=Vh+(long)(16*(wid&3)+(lane>>2))*KP+(wid>>2)*32+(lane&3)*8;
  const unsigned kdst=lds0+LDS_K+wid*1024, vdst=lds0+LDS_V+wid*1024;
  #define DMA_K(t,slot) glds16(ksrc+(long)(t)*KVBLK*KP,(unsigned)__builtin_amdgcn_readfirstlane(kdst+(slot)))
  #define DMA_V(t,slot) glds16(vsrc+(long)(t)*KVBLK*KP,(unsigned)__builtin_amdgcn_readfirstlane(vdst+(slot)))
  const int vb0=(int)(lds0+LDS_V)+((lane>>4)&1)*32+(lane&3)*8+(4*hi+((lane&15)>>2))*64;
  const char*Kbase=shm+LDS_K; bf16x8 kf[8];
  const lds_cptr shm3=(lds_cptr)shm; const lds_cptr kp0=shm3+LDS_K+hi*1024+r32*16; const lds_cptr vp0=shm3+LDS_V+((lane>>4)&1)*32+(lane&3)*8+(4*hi+((lane&15)>>2))*64;
  DMA_K(0,0);DMA_V(0,0);DMA_K(1,SLOTB);
  bf16x8 qr[4];
  #pragma unroll
  for(int d0=0;d0<4;++d0)qr[d0]=*reinterpret_cast<const bf16x8*>(&Qw[(long)r32*QP+d0*16+hi*8]);
  float mhat=0.f,l_reg=0.f;f32x16 o[2];o[0]=f32x16{};o[1]=f32x16{};f32x16 negm=f32x16{};asm volatile("":"+v"(negm));
  #define CMASK(P0,P1,t) do{}while(0)
  bool resc=false;
  #define START(P0,P1) do{ const float rm=rowmax(P0,P1); resc=false; \
    { const float dl=rm; mhat=fadd_s(mhat,dl); \
      _Pragma("unroll") for(int r=0;r<16;++r){P0[r]=fsub_s(P0[r],dl);P1[r]=fsub_s(P1[r],dl);} \
      _Pragma("unroll") for(int r=0;r<16;++r)negm[r]=-mhat; asm volatile("":"+v"(negm)); } \
    _Pragma("unroll") for(int r=0;r<16;++r)P0[r]=__builtin_amdgcn_exp2f(P0[r]); }while(0)
  #define RESC() do{ if(resc){ asm volatile("s_waitcnt lgkmcnt(0)":::"memory"); \
      _Pragma("unroll") for(int d_=0;d_<2;++d_) _Pragma("unroll") for(int r=0;r<16;++r)o[d_][r]*=wsf[crow(r,hi)]; } }while(0)
  f32x16 pA0,pA1,pB0,pB1;
  int sl_prev=0,sl_cur=0,sl_next=SLOTB;
  #define ROT() do{sl_prev=sl_cur;sl_cur=sl_next;sl_next=(sl_next==(NSLOT-1)*SLOTB)?0:sl_next+SLOTB;}while(0)
  DMA_K(2,2*SLOTB);
  WAIT_BAR(3);
  qkt(pA0,pA1,Kbase,qr,negm,r32,hi);asm volatile("s_nop 15\n\ts_nop 7":"+v"(pA0),"+v"(pA1));CMASK(pA0,pA1,0);
  START(pA0,pA1);
  _Pragma("unroll") for(int r=0;r<16;++r)pA1[r]=__builtin_amdgcn_exp2f(pA1[r]);
  WAIT_BAR(0);
  DMA_K(3,0);DMA_V(1,SLOTB);
  ROT();
  kload8(kf,kp0+sl_cur);
  WAIT_BAR(2);
  s16x4 vlo[8],vhi[8]; u32x4 pw0,pw1,pw2,pw3;
  #define PKW(P,B) cvtpk_s(P[B],P[B+1])
  #define PAF(k) __builtin_bit_cast(bf16x8,pw##k)
  #define VFR(i) (bf16x8){vlo[i][0],vlo[i][1],vlo[i][2],vlo[i][3],vhi[i][0],vhi[i][1],vhi[i][2],vhi[i][3]}
  #define PIN(x) asm volatile("":"+v"(x))
  #define MX3(a,b,c) __builtin_fmaxf(__builtin_fmaxf((a),(b)),(c))
  #define GAPA(MF,A0,A1,A2,A3,W0,W1,PW) do{ MF; sacc+=A0; sacc+=A1; sacc+=A2; sacc+=A3; PIN(sacc); W0; W1; PIN(PW); SBAR(); }while(0)
  #define EX(v) __builtin_amdgcn_exp2f(v)
  #define GAPB(MF,X,B) do{ MF; X[B]=EX(X[B]); X[B+1]=EX(X[B+1]); X[B+2]=EX(X[B+2]); X[B+3]=EX(X[B+3]); PIN(X); SBAR(); }while(0)
  #define VRD(i) do{ vlo[i]=vtr(vp_+(((i)>>2)*4096+((i)&3)*1024)); vhi[i]=vtr(vp_+(((i)>>2)*4096+((i)&3)*1024+512)); }while(0)
  #define KRD(G,j) do{ if(G){ kload2(kf,kp0+sl_next,j); SBAR(); } }while(0)
  #define STEP(C0,C1,P0,P1,t,GK,GV,GL) do{ SBAR(); \
    const lds_cptr vp_=vp0+sl_prev; \
    VRD(0); SBAR(); float sacc=(P0[0]+P0[1]); \
    GAPA(C0=__builtin_amdgcn_mfma_f32_32x32x16_bf16(kf[0],qr[0],negm,0,0,0), P0[2],P0[3],P0[4],P0[5],     pw0[0]=PKW(P0,0), pw0[1]=PKW(P0,2), pw0); \
    VRD(4); SBAR(); GAPA(C1=__builtin_amdgcn_mfma_f32_32x32x16_bf16(kf[1],qr[0],negm,0,0,0), P0[6],P0[7],P0[8],P0[9],     pw0[2]=PKW(P0,4), pw0[3]=PKW(P0,6), pw0); \
    VRD(1); SBAR(); GAPA(C0=__builtin_amdgcn_mfma_f32_32x32x16_bf16(kf[2],qr[1],C0,0,0,0),   P0[10],P0[11],P0[12],P0[13], pw1[0]=PKW(P0,8), pw1[1]=PKW(P0,10), pw1); \
    VRD(5); SBAR(); GAPA(C1=__builtin_amdgcn_mfma_f32_32x32x16_bf16(kf[3],qr[1],C1,0,0,0),   P0[14],P0[15],P1[0],P1[1],   pw1[2]=PKW(P0,12),pw1[3]=PKW(P0,14), pw1); \
    VRD(2); SBAR(); GAPA(C0=__builtin_amdgcn_mfma_f32_32x32x16_bf16(kf[4],qr[2],C0,0,0,0),   P1[2],P1[3],P1[4],P1[5],     pw2[0]=PKW(P1,0), pw2[1]=PKW(P1,2), pw2); \
    VRD(6); SBAR(); GAPA(C1=__builtin_amdgcn_mfma_f32_32x32x16_bf16(kf[5],qr[2],C1,0,0,0),   P1[6],P1[7],P1[8],P1[9],     pw2[2]=PKW(P1,4), pw2[3]=PKW(P1,6), pw2); \
    VRD(3); SBAR(); GAPA(C0=__builtin_amdgcn_mfma_f32_32x32x16_bf16(kf[6],qr[3],C0,0,0,0),   P1[10],P1[11],P1[12],P1[13], pw3[0]=PKW(P1,8), pw3[1]=PKW(P1,10), pw3); \
    VRD(7); SBAR(); GAPA(C1=__builtin_amdgcn_mfma_f32_32x32x16_bf16(kf[7],qr[3],C1,0,0,0),   P1[14],P1[15],0.f,0.f,       pw3[2]=PKW(P1,12),pw3[3]=PKW(P1,14), pw3); \
    l_reg+=sacc; \
    if(GK){DMA_K((t)+3,sl_cur);} if(GV){DMA_V((t)+1,sl_next);} \
    CMASK(C0,C1,t); \
    { float a=MX3(C0[0],C0[1],C1[0]),b=MX3(C0[2],C0[3],C1[1]); a=MX3(a,C1[2],C1[3]); \
      _Pragma("unroll") for(int r=4;r<16;r+=4){a=MX3(a,C0[r],C0[r+1]);b=MX3(b,C0[r+2],C0[r+3]);a=MX3(a,C1[r],C1[r+1]);b=MX3(b,C1[r+2],C1[r+3]);} \
      float rm=__builtin_fmaxf(a,b); { auto rr=__builtin_amdgcn_permlane32_swap(__float_as_uint(rm),__float_as_uint(rm),false,false); rm=__builtin_fmaxf(__uint_as_float(rr[0]),__uint_as_float(rr[1])); } \
      resc=false; \
      if(__builtin_expect(__any(rm>(float)THRL),0)){ const float dl=__builtin_fmaxf(rm,0.f); mhat+=dl; \
        _Pragma("unroll") for(int r=0;r<16;++r){C0[r]-=dl;C1[r]-=dl;} \
        _Pragma("unroll") for(int r=0;r<16;++r)negm[r]=-mhat; asm volatile("":"+v"(negm)); \
        const float f=__builtin_amdgcn_exp2f(-dl); l_reg*=f; if(hi==0)wsf[r32]=f; resc=true; } } \
    SBAR(); \
    GAPB(o[0]=__builtin_amdgcn_mfma_f32_32x32x16_bf16(PAF(0),VFR(0),o[0],0,0,0), C0,0); \
    GAPB(o[1]=__builtin_amdgcn_mfma_f32_32x32x16_bf16(PAF(0),VFR(4),o[1],0,0,0), C0,4); \
    KRD(GL,0); GAPB(o[0]=__builtin_amdgcn_mfma_f32_32x32x16_bf16(PAF(1),VFR(1),o[0],0,0,0), C0,8); \
    KRD(GL,1); GAPB(o[1]=__builtin_amdgcn_mfma_f32_32x32x16_bf16(PAF(1),VFR(5),o[1],0,0,0), C0,12); \
    KRD(GL,2); GAPB(o[0]=__builtin_amdgcn_mfma_f32_32x32x16_bf16(PAF(2),VFR(2),o[0],0,0,0), C1,0); \
    KRD(GL,3); GAPB(o[1]=__builtin_amdgcn_mfma_f32_32x32x16_bf16(PAF(2),VFR(6),o[1],0,0,0), C1,4); \
    GAPB(o[0]=__builtin_amdgcn_mfma_f32_32x32x16_bf16(PAF(3),VFR(3),o[0],0,0,0), C1,8); \
    GAPB(o[1]=__builtin_amdgcn_mfma_f32_32x32x16_bf16(PAF(3),VFR(7),o[1],0,0,0), C1,12); \
    }while(0)
  int t=1;
  #undef CMASK
  #define CMASK(P0,P1,t) do{}while(0)
  for(;t+5<NT;t+=2){
    STEP(pB0,pB1,pA0,pA1,t,true,true,true);     WAIT_BAR(2); RESC(); ROT();
    STEP(pA0,pA1,pB0,pB1,t+1,true,true,true);   WAIT_BAR(2); RESC(); ROT();
  }
  #undef CMASK
  #define CMASK(P0,P1,t) do{}while(0)
  #define ENDW(tt) do{ if((tt)+3<NT){WAIT_BAR(2);} else if((tt)+2<NT){WAIT_BAR(1);} else {WAIT_BAR(0);} }while(0)
  for(;t+1<NT;t+=2){
    STEP(pB0,pB1,pA0,pA1,t,(t+3<NT),(t+1<NT),(t+1<NT));       ENDW(t);   RESC(); ROT();
    STEP(pA0,pA1,pB0,pB1,t+1,(t+4<NT),(t+2<NT),(t+2<NT));     ENDW(t+1); RESC(); ROT();
  }
  STEP(pB0,pB1,pA0,pA1,NT-1,false,false,false); RESC();
  { float sacc=pB0[0]+pB0[1]; _Pragma("unroll") for(int r=2;r<16;++r)sacc+=pB0[r]; _Pragma("unroll") for(int r=0;r<16;++r)sacc+=pB1[r]; l_reg+=sacc;
    pw0=(u32x4){PKW(pB0,0),PKW(pB0,2),PKW(pB0,4),PKW(pB0,6)};pw1=(u32x4){PKW(pB0,8),PKW(pB0,10),PKW(pB0,12),PKW(pB0,14)};pw2=(u32x4){PKW(pB1,0),PKW(pB1,2),PKW(pB1,4),PKW(pB1,6)};pw3=(u32x4){PKW(pB1,8),PKW(pB1,10),PKW(pB1,12),PKW(pB1,14)};
    SBAR(); pv(o,vb0+sl_cur,PAF(0),PAF(1),PAF(2),PAF(3)); }
  #undef PKW
  #undef PAF
  #undef VFR
  #undef PIN
  #undef MX3
  #undef GAPA
  #undef GAPB
  #undef EX
  #undef VRD
  #undef KRD
  #undef STEP
  #undef ENDW
  {auto rr=__builtin_amdgcn_permlane32_swap(__float_as_uint(l_reg),__float_as_uint(l_reg),false,false);l_reg=__uint_as_float(rr[0])+__uint_as_float(rr[1]);}
  if(hi==0)wsf[32+r32]=l_reg;asm volatile("s_waitcnt lgkmcnt(0)":::"memory");
  float rli[16];
  #pragma unroll
  for(int r=0;r<16;++r)rli[r]=__builtin_amdgcn_rcpf(wsf[32+crow(r,hi)]);
  bf16*Ow=Ou+(long)(wid*QBLK)*OP;
  { bf16*stg=(bf16*)(shm+LDS_OST)+wid*2048;
    #pragma unroll
    for(int r=0;r<16;++r){const int orow=crow(r,hi);
      #pragma unroll
      for(int d0=0;d0<2;++d0)stg[orow*64+d0*32+r32]=__float2bfloat16(o[d0][r]*rli[r]);}
    asm volatile("s_waitcnt lgkmcnt(0)":::"memory");
    #pragma unroll
    for(int i=0;i<4;++i){const int row=i*8+(lane>>3),ch=lane&7; const u32x4 v=*(const u32x4*)(stg+row*64+ch*8); ATTN_STORE16(Ow+(long)row*OP+ch*8,v);} }
  asm volatile("s_waitcnt lgkmcnt(0)\n\ts_barrier":::"memory");
  #undef DMA_K
  #undef DMA_V
  #undef CMASK
  #undef START
  #undef RESC
  #undef ROT
}
constexpr int ATTN_LDS_BYTES=LDS_BYTES;
#undef SBAR
#undef WAIT_BAR
}

constexpr int NWAVES = 8, NTHR = NWAVES * 64;
constexpr int NPH = 12;

constexpr int CW_QUEUE = 64;
constexpr int CW_BAR = 4096;

constexpr int RING_OFF = 0, RING_BYTES = 131072;
constexpr int LDSCTL_OFF = RING_BYTES, MISC_OFF = LDSCTL_OFF + 320;
constexpr int LDS_BYTES = 147456;
static_assert(MISC_OFF + 128 <= LDS_BYTES, "LDS map");

#define GAS __attribute__((address_space(1)))
#define LAS __attribute__((address_space(3)))
typedef unsigned short bf16;
typedef unsigned v4u __attribute__((ext_vector_type(4)));
typedef unsigned v2u __attribute__((ext_vector_type(2)));
typedef float f32x4 __attribute__((ext_vector_type(4)));
typedef short bf16x8 __attribute__((ext_vector_type(8)));
typedef GAS unsigned gu32;
#define RLX_AGENT __ATOMIC_RELAXED, __HIP_MEMORY_SCOPE_AGENT
#define LDS_WAIT() asm volatile("s_waitcnt lgkmcnt(0)" ::: "memory")
#define VM_WAIT() asm volatile("s_waitcnt vmcnt(0)" ::: "memory")
__device__ __forceinline__ unsigned f2bf(float f) { unsigned u = __builtin_bit_cast(unsigned, f); return (u + 0x7fffu + ((u >> 16) & 1u)) >> 16; }
__device__ __forceinline__ unsigned pk2(float lo, float hi) { return f2bf(lo) | (f2bf(hi) << 16); }
__device__ __forceinline__ float bf2f(unsigned short b) { return __builtin_bit_cast(float, (unsigned)b << 16); }

#define XB_TMO      128
#define XB_XCNT(j)  (256  + 64 * (j))
#define XB_XSUB(j)  (1280 + 64 * (j))
#define XB_XGEN(j)  (2304 + 64 * (j))
#define XB_TOP      3328
#define XB_TOPGEN   3392
#define XCD_BAR_WORDS 3456
#define XB_SPIN_CAP (1u << 18)
static_assert((CW_BAR + NPH * XCD_BAR_WORDS) * 4 <= (int)CTL_ZERO_BYTES, "CTL words inside the memset region");

__device__ __forceinline__ unsigned xb_ld(unsigned* p)              { return __hip_atomic_load(p, __ATOMIC_RELAXED, __HIP_MEMORY_SCOPE_AGENT); }
__device__ __forceinline__ unsigned xb_add(unsigned* p, unsigned v) { return __hip_atomic_fetch_add(p, v, __ATOMIC_RELAXED, __HIP_MEMORY_SCOPE_AGENT); }
__device__ __forceinline__ unsigned xb_xcc_id() { return (unsigned)__builtin_amdgcn_s_getreg((3 << 11) | 20) & 0xFu; }
#define XB_SPIN(cond, bar) do { unsigned _sp = 0; while (cond) { __builtin_amdgcn_s_sleep(1); \
    if ((++_sp & 255u) == 0u) { if (xb_ld(&(bar)[XB_TMO])) break; if (_sp > XB_SPIN_CAP) { atomicAdd(&(bar)[XB_TMO], 1u); break; } } } } while (0)

struct XcdBarrier { unsigned* bar; unsigned x; volatile LAS unsigned* st; };

__device__ __forceinline__ XcdBarrier xcd_barrier_post(unsigned* bar, volatile LAS unsigned* st) {
    XcdBarrier b; b.bar = bar; b.x = xb_xcc_id(); b.st = st;
    if (threadIdx.x == 0) (void)xb_add(&bar[XB_XCNT(b.x)], 1u);
    return b;
}
__device__ __forceinline__ void xcd_barrier_complete(unsigned* bar, unsigned x, unsigned& nloc, unsigned& nx) {
    const unsigned G = gridDim.x * gridDim.y * gridDim.z;
    unsigned sum, cnt, mine, sp = 0u;
    for (;;) {
        sum = 0u; cnt = 0u; mine = 0u;
#pragma unroll
        for (unsigned j = 0; j < 16; ++j) { const unsigned c = xb_ld(&bar[XB_XCNT(j)]); sum += c; cnt += (c > 0u) ? 1u : 0u; mine = (j == x) ? c : mine; }
        if (sum == G) break;
        __builtin_amdgcn_s_sleep(1);
        if ((++sp & 255u) == 0u) { if (xb_ld(&bar[XB_TMO])) break; if (sp > XB_SPIN_CAP) { atomicAdd(&bar[XB_TMO], 1u); break; } }
    }
    nloc = mine > 0u ? mine : 1u; nx = cnt > 0u ? cnt : 1u;
}
__device__ __forceinline__ void xcd_barrier(const XcdBarrier& b) {
    asm volatile("s_waitcnt vmcnt(0)" ::: "memory");
    __syncthreads();
    if (threadIdx.x == 0) {
        unsigned* bar = b.bar;
        __builtin_amdgcn_s_waitcnt(0);
        unsigned nloc = b.st[0], nx = b.st[1];
        if (nloc == 0u) { xcd_barrier_complete(bar, b.x, nloc, nx); b.st[0] = nloc; b.st[1] = nx; }
        const unsigned old = xb_add(&bar[XB_XSUB(b.x)], 1u);
        const unsigned gen = old / nloc;
        if (old + 1u == (gen + 1u) * nloc) {
            __builtin_amdgcn_fence(__ATOMIC_RELEASE, "agent");
            asm volatile("s_waitcnt vmcnt(0)" ::: "memory");
            const unsigned og = xb_add(&bar[XB_TOP], 1u);
            const unsigned tg = og / nx;
            if (og + 1u == (tg + 1u) * nx) xb_add(&bar[XB_TOPGEN], 1u);
            else XB_SPIN(xb_ld(&bar[XB_TOPGEN]) == tg, bar);
            __builtin_amdgcn_fence(__ATOMIC_ACQUIRE, "agent");
            xb_add(&bar[XB_XGEN(b.x)], 1u);
            asm volatile("s_waitcnt vmcnt(0)" ::: "memory");
        } else {
            XB_SPIN(xb_ld(&bar[XB_XGEN(b.x)]) == gen, bar);
            __builtin_amdgcn_fence(__ATOMIC_ACQUIRE, "agent");
            asm volatile("s_waitcnt vmcnt(0)" ::: "memory");
        }
    }
    __syncthreads();
}

__device__ __forceinline__ float wave_sum(float v) {
#pragma unroll
    for (int o = 1; o < 64; o <<= 1) v += __shfl_xor(v, o);
    return v;
}
struct Tens {
    const float *x_prompt, *x_sample, *c, *cache_k, *cache_v, *state_lru, *c_ctx, *w_mod, *b_mod, *norm_pre, *norm_post, *ffn_w_in, *ffn_w_out, *w_in, *w_out,
                *q_norm, *k_norm, *conv_w, *conv_b, *lru_wa, *lru_ba, *lru_wx, *lru_bx, *lru_lambda;
    float* out; unsigned char* ws;
};
__device__ __forceinline__ const float* xrow_in(const Tens& T, int R) { return R < NCTX ? T.x_prompt + (size_t)R * DM : T.x_sample + (size_t)(R - NCTX) * DM; }
__device__ __forceinline__ int cond_of_row(int R) { return R < NCTX ? 0 : 1 + ((R - NCTX) >> 12); }

__device__ __forceinline__ int lperm32(int p) { return 8 * ((p >> 2) & 3) + 4 * (p >> 4) + (p & 3); }
__device__ __forceinline__ int src_col(int mat, int n) {
    if (mat == 0) { const int pn = n >> 8, p = n & 255; return (p >> 7) * FFN + pn * 128 + (p & 127); }
    if (mat == 2) {
        const int pn = n >> 8, p = n & 255, bj = p >> 7, wc = (p >> 5) & 3, p32 = p & 31;
        if (pn < 2) return (4 * pn + wc) * 64 + bj * 32 + p32;
        if (pn == 2) return (wc < 2 ? 512 + wc * 64 : 640 + (wc - 2) * 64) + bj * 32 + p32;
        if (pn < 5) return 768 + (pn - 3) * 256 + bj * 128 + wc * 32 + lperm32(p32);
        return 1280 + (pn - 5) * 256 + bj * 128 + wc * 32 + lperm32(p32);
    }
    return n;
}
__device__ __forceinline__ void p0_transpose_item(const float* W, int K, int Nsrc, bf16* WT, int mat, LAS float* scr, int nblk, int item, int lane) {
    const int kb = item / nblk, nb = item % nblk, k0 = 64 * kb, n0 = 32 * nb;
    const int sc = src_col(mat, n0 + (lane & 31));
#pragma unroll 8
    for (int i = 0; i < 32; ++i) { const int kk = 2 * i + (lane >> 5); scr[kk * 33 + (lane & 31)] = W[(size_t)(k0 + kk) * Nsrc + sc]; }
    LDS_WAIT(); asm volatile("" ::: "memory");
    const int c = lane & 7;
#pragma unroll
    for (int j = 0; j < 4; ++j) { const int n = (lane >> 3) + 8 * j; const LAS float* s = scr + (8 * c) * 33 + n;
        v4u o; o.x = pk2(s[0 * 33], s[1 * 33]); o.y = pk2(s[2 * 33], s[3 * 33]); o.z = pk2(s[4 * 33], s[5 * 33]); o.w = pk2(s[6 * 33], s[7 * 33]);
        *(GAS v4u*)(WT + (size_t)(n0 + n) * K + k0 + 8 * c) = o; }
    LDS_WAIT(); asm volatile("" ::: "memory");
}

__device__ __forceinline__ void pre_row_store(const f32x4 (&v)[4], float ssq, const float* npre, const float* mshift, const float* mscale, bf16* hrow, int lane) {
    const float rstd = 1.0f / sqrtf(ssq * (1.0f / DM) + EPSN);
#pragma unroll
    for (int j = 0; j < 4; ++j) { const int c = 4 * lane + 256 * j;
        const f32x4 g = *(const f32x4*)(npre + c), sc = *(const f32x4*)(mscale + c), sh = *(const f32x4*)(mshift + c);
        const f32x4 h = (v[j] * rstd) * g * (sc + 1.0f) + sh;
        v2u w; w.x = pk2(h[0], h[1]); w.y = pk2(h[2], h[3]); *(GAS v2u*)(hrow + c) = w; }
}
__device__ __forceinline__ void rowpass_pre0(const Tens& T, const float* mod, bf16* H, int gw, int NGW, int lane) {
    for (int R = gw; R < MTOK; R += NGW) {
        const float* xr = xrow_in(T, R); f32x4 v[4]; float s = 0.f;
#pragma unroll
        for (int j = 0; j < 4; ++j) { v[j] = *(const f32x4*)(xr + 4 * lane + 256 * j); s += (v[j][0] * v[j][0] + v[j][1] * v[j][1]) + (v[j][2] * v[j][2] + v[j][3] * v[j][3]); }
        s = wave_sum(s);
        const float* m = mod + (size_t)cond_of_row(R) * NMOD;
        pre_row_store(v, s, T.norm_pre, m + 0 * DM, m + 1 * DM, H + (size_t)R * DM, lane);
    }
}
template <int SUB> __device__ __forceinline__ void rowpass_post(const Tens& T, const float* mod, const float* OUTF, bf16* H, float* dbg_x, int gw, int NGW, int lane) {
    const float res_w = (SUB == 1) ? 1.0f : 0.5f;
    for (int R = gw; R < MTOK; R += NGW) {
        const float* xo = (SUB == 0) ? xrow_in(T, R) : T.out + (size_t)R * DM;
        const float* orow = OUTF + (size_t)R * DM; float* xn = T.out + (size_t)R * DM;
        const float* m = mod + (size_t)cond_of_row(R) * NMOD;
        f32x4 o[4], v[4]; float s = 0.f;
#pragma unroll
        for (int j = 0; j < 4; ++j) { o[j] = *(const f32x4*)(orow + 4 * lane + 256 * j); v[j] = *(const f32x4*)(xo + 4 * lane + 256 * j);
            s += (o[j][0] * o[j][0] + o[j][1] * o[j][1]) + (o[j][2] * o[j][2] + o[j][3] * o[j][3]); }
        s = wave_sum(s);
        const float rstd = 1.0f / sqrtf(s * (1.0f / DM) + EPSN); float s2 = 0.f;
#pragma unroll
        for (int j = 0; j < 4; ++j) { const int c = 4 * lane + 256 * j;
            const f32x4 g = *(const f32x4*)(T.norm_post + SUB * DM + c), gt = *(const f32x4*)(m + (3 * SUB + 2) * DM + c);
            v[j] = v[j] + (gt * res_w) * ((o[j] * rstd) * g);
            *(f32x4*)(xn + c) = v[j];
            s2 += (v[j][0] * v[j][0] + v[j][1] * v[j][1]) + (v[j][2] * v[j][2] + v[j][3] * v[j][3]); }
#if DBG_CHECK
        if (dbg_x && (R % 641) == 0) {
#pragma unroll
            for (int j = 0; j < 4; ++j) *(f32x4*)(dbg_x + (size_t)(R / 641) * DM + 4 * lane + 256 * j) = v[j];
        }
#endif
        if (SUB < 2) { s2 = wave_sum(s2); pre_row_store(v, s2, T.norm_pre + (SUB + 1) * DM, m + (3 * (SUB + 1)) * DM, m + (3 * (SUB + 1) + 1) * DM, H + (size_t)R * DM, lane); }
    }
}

__device__ __forceinline__ void p0_modulation(const Tens& T, float* mod, LAS unsigned char* lds, int tid, int lane, int wave, int G) {
    LAS float* sl = (LAS float*)lds;
    LAS float* red = (LAS float*)(lds + 9 * 1024 * 4);
    for (int i = tid; i < 9 * DM; i += NTHR) { const int ci = i >> 10, k = i & 1023; const float v = ci == 0 ? T.c_ctx[k] : T.c[(ci - 1) * DM + k]; sl[i] = v / (1.0f + __expf(-v)); }
    __syncthreads();
    for (int it = blockIdx.x; it < NMOD / 64; it += G) {
        const int col = it * 64 + lane; float acc[9];
#pragma unroll
        for (int ci = 0; ci < 9; ++ci) acc[ci] = 0.f;
        const float* wp = T.w_mod + (size_t)(wave * 128) * NMOD + col;
#pragma unroll 8
        for (int k = 0; k < 128; ++k) { const float w = wp[(size_t)k * NMOD];
#pragma unroll
            for (int ci = 0; ci < 9; ++ci) acc[ci] += sl[ci * 1024 + wave * 128 + k] * w; }
#pragma unroll
        for (int ci = 0; ci < 9; ++ci) red[(wave * 9 + ci) * 64 + lane] = acc[ci];
        __syncthreads();
        for (int i = tid; i < 9 * 64; i += NTHR) { const int ci = i >> 6, l = i & 63; float s = 0.f;
#pragma unroll
            for (int w = 0; w < 8; ++w) s += red[(w * 9 + ci) * 64 + l];
            mod[(size_t)ci * NMOD + it * 64 + l] = s + T.b_mod[it * 64 + l]; }
        __syncthreads();
    }
}
__device__ __forceinline__ void p0_rope_table(float* rope, int tid) {
    if (tid < 16) {
        double th = 1.0; for (int i = 0; i < tid; ++i) th *= 0.56234132519034908;
        double c = 1.0, s = th, tc = 1.0, ts = th; const double x2 = th * th;
        for (int k = 1; k < 14; ++k) { tc *= -x2 / ((2.0 * k - 1.0) * (2.0 * k)); ts *= -x2 / ((2.0 * k) * (2.0 * k + 1.0)); c += tc; s += ts; }
        double pc = 1.0, ps = 0.0;
        for (int pos = 0; pos < 64; ++pos) { rope[pos * 32 + tid * 2] = (float)pc; rope[pos * 32 + tid * 2 + 1] = (float)ps;
            const double nc = pc * c - ps * s, ns = ps * c + pc * s; pc = nc; ps = ns; }
    }
}

constexpr int LRU_TB = 64;
constexpr int LRU_WT = 0;
constexpr int LRU_XCB = LRU_WT + 4 * 64 * 72 * 2;
constexpr int LRU_XCF = LRU_XCB + 64 * 72 * 2;
constexpr int LRU_AL = LRU_XCF + 64 * 64 * 4;
constexpr int LRU_BL = LRU_AL + 64 * 64 * 4;
constexpr int LRU_CP = LRU_BL + 64 * 64 * 4;
constexpr int LRU_CH = LRU_CP + 8 * 64 * 4;
constexpr int LRU_HP = LRU_CH + 8 * 64 * 4;
constexpr int LRU_END = LRU_HP + 2 * 64 * 4;
static_assert(LRU_END <= RING_BYTES, "lru LDS");
__device__ __forceinline__ float sigmoid_f(float x) { return __builtin_amdgcn_rcpf(1.0f + __expf(-x)); }
__device__ __forceinline__ void lru_item(const Tens& T, LAS unsigned char* lds, const bf16* XL, const bf16* GL, float* HF, bf16* HB,
                                         int rowbase, int S, int n, const float* h0  , float* hfin  ) {
    int tid_l = threadIdx.x; asm volatile("" : "+v"(tid_l));
    const int tid = tid_l, lane = tid & 63, wave = __builtin_amdgcn_readfirstlane(tid >> 6);
    LAS bf16* WT = (LAS bf16*)(lds + LRU_WT); LAS bf16* XCB = (LAS bf16*)(lds + LRU_XCB); LAS float* XCF = (LAS float*)(lds + LRU_XCF);
    LAS float* AL = (LAS float*)(lds + LRU_AL); LAS float* BL = (LAS float*)(lds + LRU_BL); LAS float* CP = (LAS float*)(lds + LRU_CP); LAS float* CH = (LAS float*)(lds + LRU_CH);
    LAS float* HP = (LAS float*)(lds + LRU_HP);
    __syncthreads();
    for (int idx = tid; idx < 4 * 4096; idx += NTHR) { const int g = idx >> 12, k = (idx >> 6) & 63, e = idx & 63;
        const float* src = (g & 1) ? T.lru_wx : T.lru_wa; WT[(g * 64 + e) * 72 + k] = (bf16)f2bf(src[((size_t)((g >> 1) * 8 + n) * 64 + k) * 64 + e]); }
    const int cc = tid & 63, tq = tid >> 6, gcc = n * 64 + cc;
    const float cw0 = T.conv_w[0 * 512 + gcc], cw1 = T.conv_w[1 * 512 + gcc], cw2 = T.conv_w[2 * 512 + gcc], cw3 = T.conv_w[3 * 512 + gcc], cb = T.conv_b[gcc];
    const int rt = wave & 3, hh = wave >> 2, fr = lane & 15, fq = lane >> 4;
    for (int dir = 0; dir < 2; ++dir) {
        float ba_[2], bx_[2], sp_[2];
#pragma unroll
        for (int cp = 0; cp < 2; ++cp) { const int gc = n * 64 + 32 * hh + 16 * cp + fr; ba_[cp] = T.lru_ba[dir * 512 + gc]; bx_[cp] = T.lru_bx[dir * 512 + gc];
            const float lam = T.lru_lambda[dir * 512 + gc]; const float e = __expf(-lam); sp_[cp] = (e < 0.05f) ? e * (1.0f - e * (0.5f - e * (0.33333334f - 0.25f * e))) : __logf(1.0f + e); }
        if (tid < 64) HP[tid] = h0 ? h0[dir * 512 + n * 64 + tid] : 0.0f;
        const int nblk = S / LRU_TB;
        float win[11];
        { const int tf = dir ? S - LRU_TB : 0;
#pragma unroll
          for (int i = 0; i < 11; ++i) { const int t = tf + 8 * tq - 2 + i; win[i] = (t >= 0 && t < S) ? bf2f(XL[(size_t)(rowbase + t) * 512 + gcc]) : 0.0f; } }
        for (int bi = 0; bi < nblk; ++bi) {
            const int t0 = dir ? S - LRU_TB * (bi + 1) : LRU_TB * bi;
            {
#pragma unroll
              for (int i = 0; i < 8; ++i) { const float xc = cb + cw0 * win[i] + cw1 * win[i + 1] + cw2 * win[i + 2] + cw3 * win[i + 3];
                  XCF[(8 * tq + i) * 64 + cc] = xc; XCB[(8 * tq + i) * 72 + cc] = (bf16)f2bf(xc); }
              if (bi + 1 < nblk) { const int t1 = dir ? S - LRU_TB * (bi + 2) : LRU_TB * (bi + 1);
#pragma unroll
                  for (int i = 0; i < 11; ++i) { const int t = t1 + 8 * tq - 2 + i; win[i] = (t >= 0 && t < S) ? bf2f(XL[(size_t)(rowbase + t) * 512 + gcc]) : 0.0f; } } }
            float hfv[8], glv[8];
            if (dir) {
#pragma unroll
                for (int i = 0; i < 8; ++i) { const int tau = 8 * tq + i, t = t0 + (LRU_TB - 1 - tau); hfv[i] = HF[(size_t)(rowbase + t) * 512 + gcc]; glv[i] = bf2f(GL[(size_t)(rowbase + t) * 512 + gcc]); }
            }
            __syncthreads();
            { f32x4 ga[2], gx[2];
#pragma unroll
              for (int cp = 0; cp < 2; ++cp) { ga[cp] = (f32x4){0.f, 0.f, 0.f, 0.f}; gx[cp] = (f32x4){0.f, 0.f, 0.f, 0.f}; }
#pragma unroll
              for (int ks = 0; ks < 2; ++ks) {
                  const bf16x8 af = *(const LAS bf16x8*)(XCB + (16 * rt + fr) * 72 + 8 * fq + 32 * ks);
#pragma unroll
                  for (int cp = 0; cp < 2; ++cp) { const int e = 32 * hh + 16 * cp + fr;
                      const bf16x8 bfa = *(const LAS bf16x8*)(WT + ((2 * dir + 0) * 64 + e) * 72 + 8 * fq + 32 * ks);
                      const bf16x8 bfx = *(const LAS bf16x8*)(WT + ((2 * dir + 1) * 64 + e) * 72 + 8 * fq + 32 * ks);
                      ga[cp] = __builtin_amdgcn_mfma_f32_16x16x32_bf16(af, bfa, ga[cp], 0, 0, 0);
                      gx[cp] = __builtin_amdgcn_mfma_f32_16x16x32_bf16(af, bfx, gx[cp], 0, 0, 0); } }
#pragma unroll
              for (int cp = 0; cp < 2; ++cp)
#pragma unroll
                  for (int j = 0; j < 4; ++j) { const int tl = 16 * rt + 4 * fq + j, c = 32 * hh + 16 * cp + fr;
                      const float r = sigmoid_f(ga[cp][j] + ba_[cp]), ig = sigmoid_f(gx[cp][j] + bx_[cp]);
                      const float la = -8.0f * r * sp_[cp]; const float a = __expf(la); const float y2 = 2.0f * la;
                      const float om = (y2 > -0.05f) ? -y2 * (1.0f + y2 * (0.5f + y2 * (0.16666667f + y2 * 0.041666668f))) : 1.0f - a * a;
                      const float b = sqrtf(om) * (ig * XCF[tl * 64 + c]);
                      const int tau = dir ? (LRU_TB - 1 - tl) : tl; AL[tau * 64 + c] = a; BL[tau * 64 + c] = b; } }
            __syncthreads();
            float av[8], bv[8];
            { float P = 1.0f, Hh = 0.0f;
#pragma unroll
              for (int i = 0; i < 8; ++i) { av[i] = AL[(8 * tq + i) * 64 + cc]; bv[i] = BL[(8 * tq + i) * 64 + cc]; Hh = av[i] * Hh + bv[i]; P *= av[i]; }
              CP[tq * 64 + cc] = P; CH[tq * 64 + cc] = Hh; }
            __syncthreads();
            { float h = HP[(bi & 1) * 64 + cc];
              for (int jj = 0; jj < tq; ++jj) h = CP[jj * 64 + cc] * h + CH[jj * 64 + cc];
#pragma unroll
              for (int i = 0; i < 8; ++i) { h = av[i] * h + bv[i]; const int tau = 8 * tq + i, t = t0 + (dir ? (LRU_TB - 1 - tau) : tau);
                  if (!dir) HF[(size_t)(rowbase + t) * 512 + gcc] = h;
                  else HB[(size_t)(rowbase + t) * DM + 512 + gcc] = (bf16)f2bf((hfv[i] + h) * glv[i]); }
              if (tq == 7) { HP[((bi + 1) & 1) * 64 + cc] = h; if (hfin && bi == nblk - 1) hfin[dir * 512 + gcc] = h; } }
        }
        __syncthreads();
    }
}


struct Args { const float* in[24]; float* out; unsigned char* ws; int ph_lo, ph_hi, li, pad; };
constexpr int Q_LRU_L = 64, Q_ATT_L = 1024, Q_ATT_C = 256, Q_LRU_C = 256, Q_ITEMS = Q_LRU_L + Q_ATT_L + Q_ATT_C + Q_LRU_C;

#define MK_TENS(T) Tens T; { int z_ = 0; asm volatile("" : "+s"(z_)); \
    T.x_prompt = args.in[0] + z_; T.x_sample = args.in[1] + z_; T.c = args.in[2] + z_; T.cache_k = args.in[3] + z_; T.cache_v = args.in[4] + z_; T.state_lru = args.in[5] + z_; T.c_ctx = args.in[6] + z_; \
    T.w_mod = args.in[7] + z_; T.b_mod = args.in[8] + z_; T.norm_pre = args.in[9] + z_; T.norm_post = args.in[10] + z_; T.ffn_w_in = args.in[11] + z_; T.ffn_w_out = args.in[12] + z_; T.w_in = args.in[13] + z_; \
    T.w_out = args.in[14] + z_; T.q_norm = args.in[15] + z_; T.k_norm = args.in[16] + z_; T.conv_w = args.in[17] + z_; T.conv_b = args.in[18] + z_; T.lru_wa = args.in[19] + z_; T.lru_ba = args.in[20] + z_; \
    T.lru_wx = args.in[21] + z_; T.lru_bx = args.in[22] + z_; T.lru_lambda = args.in[23] + z_; T.out = args.out + z_; T.ws = args.ws + z_; }
__global__ void __launch_bounds__(NTHR, 2) fwd_kernel(Args args) {
    extern __shared__ __attribute__((aligned(16))) unsigned char lds_raw[];
    LAS unsigned char* lds = (LAS unsigned char*)lds_raw;
    volatile LAS unsigned* MISC = (volatile LAS unsigned*)(lds + MISC_OFF);
    const int tid0 = threadIdx.x;
    const int G = gridDim.x, bx = blockIdx.x;
    const int vcu = (G % 8 == 0) ? (bx % 8) * (G / 8) + bx / 8 : bx;
    gu32* ctl = (gu32*)(args.ws + WS_CTL);
    for (int u = tid0; u < (LDS_BYTES - LDSCTL_OFF) / 4; u += NTHR) ((LAS unsigned*)(lds + LDSCTL_OFF))[u] = 0u;
    __syncthreads();
    const int lo = args.ph_lo, hi = args.ph_hi;
    XcdBarrier bar; bar.bar = (unsigned*)(ctl + CW_BAR) + args.li * XCD_BAR_WORDS; bar.x = 0; bar.st = nullptr;
    if (hi - lo > 1) bar = xcd_barrier_post((unsigned*)(ctl + CW_BAR) + args.li * XCD_BAR_WORDS, MISC + 8);
    const int NGW = G * NWAVES;

    for (int ph = lo; ph < hi; ++ph) {
        if (ph > lo) xcd_barrier(bar);
        int tid_l = threadIdx.x; asm volatile("" : "+v"(tid_l));
        const int tid = tid_l, lane = tid & 63, wave = __builtin_amdgcn_readfirstlane(tid >> 6), gw = vcu * NWAVES + wave;
        unsigned char* ws = args.ws; asm volatile("" : "+s"(ws));
        float* MOD = (float*)(ws + WS_MOD); float* ROPE = (float*)(ws + WS_ROPE);
        bf16* WUP1 = (bf16*)(ws + WS_WUP1); bf16* WUP2 = (bf16*)(ws + WS_WUP2); bf16* WDN1 = (bf16*)(ws + WS_WDN1); bf16* WDN2 = (bf16*)(ws + WS_WDN2);
        bf16* WIN = (bf16*)(ws + WS_WIN); bf16* WOUT = (bf16*)(ws + WS_WOUT);
        bf16* HB = (bf16*)(ws + WS_H); float* OUTF = (float*)(ws + WS_OUTF); bf16* ACT = (bf16*)(ws + WS_ACT);
        bf16* QB_ = (bf16*)(ws + WS_Q); bf16* XL = (bf16*)(ws + WS_XL); bf16* GL = (bf16*)(ws + WS_GL); float* HF = (float*)(ws + WS_HF);
        bf16* KL = (bf16*)(ws + WS_KL); bf16* VL = (bf16*)(ws + WS_VL); bf16* KC = (bf16*)(ws + WS_KC); bf16* VC = (bf16*)(ws + WS_VC);
        float* dbgx = (float*)(ws + WS_DBG);
        float* outl = args.out; asm volatile("" : "+s"(outl)); float* OUT_CK = outl + (size_t)MTOK * DM; float* OUT_CV = OUT_CK + (size_t)NCTX * 128; float* OUT_ST = OUT_CV + (size_t)NCTX * 128;

        switch (ph) {
        case 0: {
            MK_TENS(T);
            p0_modulation(T, MOD, lds, tid, lane, wave, G);
            if (bx == G - 1) p0_rope_table(ROPE, tid);
            __syncthreads();
            LAS float* scr = (LAS float*)(lds + RING_OFF + wave * 16384);
            constexpr int I_UP = (DM / 64) * (2 * FFN / 32), I_DN = (FFN / 64) * (DM / 32), I_IN = (DM / 64) * (INC / 32), I_OUT = (DM / 64) * (DM / 32);
            constexpr int NITEMS = 2 * I_UP + 2 * I_DN + I_IN + I_OUT;
            for (int it = gw; it < NITEMS; it += NGW) {
                int r = it;
                if (r < I_UP) { p0_transpose_item(T.ffn_w_in, DM, 2 * FFN, WUP1, 0, scr, 2 * FFN / 32, r, lane); continue; } r -= I_UP;
                if (r < I_UP) { p0_transpose_item(T.ffn_w_in + (size_t)DM * 2 * FFN, DM, 2 * FFN, WUP2, 0, scr, 2 * FFN / 32, r, lane); continue; } r -= I_UP;
                if (r < I_DN) { p0_transpose_item(T.ffn_w_out, FFN, DM, WDN1, 1, scr, DM / 32, r, lane); continue; } r -= I_DN;
                if (r < I_DN) { p0_transpose_item(T.ffn_w_out + (size_t)FFN * DM, FFN, DM, WDN2, 1, scr, DM / 32, r, lane); continue; } r -= I_DN;
                if (r < I_IN) { p0_transpose_item(T.w_in, DM, INC, WIN, 2, scr, INC / 32, r, lane); continue; } r -= I_IN;
                p0_transpose_item(T.w_out, DM, DM, WOUT, 1, scr, DM / 32, r, lane);
            }
        } break;
        case 1: { MK_TENS(T); rowpass_pre0(T, MOD, HB, gw, NGW, lane); } break;
        case 2: case 9: {
            pg8::Gemm g{HB, ph == 2 ? WUP1 : WUP2, MTOK, 2 * FFN, DM}; pg8::StaticOrder S; S.init(MTOK, 2 * FFN, G, bx);
            pg8::EpiSwiglu E{ACT};
            pg8::gemm_phase<pg8::EpiSwiglu, pg8::StaticOrder, true, true>(lds + RING_OFF, g, S, E);
        } break;
        case 3: case 7: case 10: {
            pg8::Gemm g{ph == 7 ? HB : ACT, ph == 3 ? WDN1 : (ph == 7 ? WOUT : WDN2), MTOK, DM, ph == 7 ? DM : FFN}; pg8::StaticOrder S; S.init(MTOK, DM, G, bx);
            pg8::EpiF32 E{OUTF, DM};
            pg8::gemm_phase<pg8::EpiF32, pg8::StaticOrder, true, true>(lds + RING_OFF, g, S, E);
        } break;
        case 4: {
            MK_TENS(T);
            rowpass_post<0>(T, MOD, OUTF, HB, dbgx, gw, NGW, lane);
            for (int i = bx * NTHR + tid; i < 2 * 8 * PAST * 32; i += G * NTHR) {
                const int kv = i >= 8 * PAST * 32, e = kv ? i - 8 * PAST * 32 : i, b = e / (PAST * 32), p = (e / 32) % PAST, c4 = e % 32;
                const f32x4 v = *(const f32x4*)((kv ? T.cache_v : T.cache_k) + ((size_t)(b * PAST + p) * 128 + c4 * 4));
                v2u w; w.x = pk2(v[0], v[1]); w.y = pk2(v[2], v[3]);
                *(GAS v2u*)((kv ? VL : KL) + ((size_t)b * TKL + SEQ_L + p) * 128 + c4 * 4) = w;
            }
        } break;
        case 5: {
            pg8::Gemm g{HB, WIN, MTOK, INC, DM}; pg8::StaticOrder S; S.init(MTOK, INC, G, bx);
            pg8::EpiInProj E{ws, outl, args.in[15], args.in[16]};
            pg8::gemm_phase<pg8::EpiInProj, pg8::StaticOrder, true, true>(lds + RING_OFF, g, S, E);
        } break;
        case 6: {
#define Q_NEXT(word) ({ __syncthreads(); if (tid == 0) MISC[16] = __hip_atomic_fetch_add((unsigned*)(ctl + CW_QUEUE + 64 * (word)), 1u, RLX_AGENT); __syncthreads(); __builtin_amdgcn_readfirstlane((int)MISC[16]); })
#ifndef NO_LRU
            { MK_TENS(T);
              for (;;) { const int it = Q_NEXT(0); if (it >= Q_LRU_L + Q_LRU_C) break;
                  const bool latent = it < Q_LRU_L; const int a = latent ? it : it - Q_LRU_L, b = a >> 3, n = a & 7;
                  lru_item(T, lds + RING_OFF, XL, GL, HF, HB, latent ? NCTX + b * SEQ_L : b * SEQ_C, latent ? SEQ_L : SEQ_C, n, latent ? T.state_lru + b * 1024 : nullptr, latent ? nullptr : OUT_ST + b * 1024); } }
#endif
#ifndef NO_ATT
            { unsigned char* ws2 = args.ws; asm volatile("" : "+s"(ws2));
              const attn_body::bf16* Qb2 = (const attn_body::bf16*)(ws2 + WS_Q); const attn_body::bf16* KL2 = (const attn_body::bf16*)(ws2 + WS_KL); const attn_body::bf16* VL2 = (const attn_body::bf16*)(ws2 + WS_VL);
              const attn_body::bf16* KC2 = (const attn_body::bf16*)(ws2 + WS_KC); const attn_body::bf16* VC2 = (const attn_body::bf16*)(ws2 + WS_VC); attn_body::bf16* HB2 = (attn_body::bf16*)(ws2 + WS_H);
              for (;;) { const int it = Q_NEXT(1); if (it >= Q_ATT_L + Q_ATT_C) break;
                const attn_body::bf16 *Qu, *Kh, *Vh; attn_body::bf16* Ou; int NT;
                if (it < Q_ATT_L) { const int a = it, g = a >> 6, b = g >> 1, kvh = g & 1, head = kvh * 4 + ((a >> 4) & 3), qb = a & 15; const size_t row = (size_t)NCTX + (size_t)b * SEQ_L + qb * 256;
                    Qu = Qb2 + row * 512 + head * 64; Kh = KL2 + (size_t)b * TKL * 128 + kvh * 64; Vh = VL2 + (size_t)b * TKL * 128 + kvh * 64; Ou = HB2 + row * DM + head * 64; NT = TKL / 64; }
                else { const int a = it - Q_ATT_L, b = a >> 3, head = a & 7, kvh = head >> 2; const size_t row = (size_t)b * SEQ_C;
                    Qu = Qb2 + row * 512 + head * 64; Kh = KC2 + row * 128 + kvh * 64; Vh = VC2 + row * 128 + kvh * 64; Ou = HB2 + row * DM + head * 64; NT = SEQ_C / 64; }
                attn_body::attn_unit<8, 512, 128, DM>(Qu, Kh, Vh, NT, Ou, (char*)lds_raw + RING_OFF); } }
#endif
#undef Q_NEXT
        } break;
        case 8: { MK_TENS(T); rowpass_post<1>(T, MOD, OUTF, HB, dbgx + (size_t)64 * DM, gw, NGW, lane); } break;
        case 11: { MK_TENS(T); rowpass_post<2>(T, MOD, OUTF, HB, nullptr, gw, NGW, lane); } break;
        default: break;
        }
    }
}


#if DBG_CHECK
constexpr size_t WS_DIAG = 1 * MiB + 400 * 1024;
constexpr int NSAMP = 64, SAMP_STRIDE = 641;
__device__ __forceinline__ void dg_accum(float* d, float e2, float r2) {
    e2 = wave_sum(e2); r2 = wave_sum(r2);
    if ((threadIdx.x & 63) == 0) { atomicAdd(d, e2); atomicAdd(d + 1, r2); }
}
__device__ __forceinline__ float dsilu(float v) { return v / (1.0f + expf(-v)); }
__device__ __forceinline__ float dgelu(float x) { return 0.5f * x * (1.0f + tanhf(0.7978845608028654f * (x + 0.044715f * x * x * x))); }
__global__ void chk_mod(Tens T, float* diag) {
    const int i = blockIdx.x * blockDim.x + threadIdx.x; float e2 = 0.f, r2 = 0.f;
    if (i < 9 * NMOD) { const int ci = i / NMOD, col = i % NMOD; float s = 0.f;
        for (int k = 0; k < DM; ++k) { const float c = ci == 0 ? T.c_ctx[k] : T.c[(ci - 1) * DM + k]; s += dsilu(c) * T.w_mod[(size_t)k * NMOD + col]; }
        s += T.b_mod[col]; const float g = ((const float*)(T.ws + WS_MOD))[i]; e2 = (g - s) * (g - s); r2 = s * s; }
    dg_accum(diag, e2, r2);
}
__device__ __forceinline__ float blk_sum(float v, float* sh) { v = wave_sum(v); __syncthreads(); if ((threadIdx.x & 63) == 0) sh[threadIdx.x >> 6] = v; __syncthreads(); return sh[0] + sh[1] + sh[2] + sh[3]; }
__global__ void chk_pre0(Tens T, float* diag) {
    __shared__ float sh[4];
    const int R = blockIdx.x * SAMP_STRIDE, tid = threadIdx.x; const float* xr = xrow_in(T, R); const float* m = (const float*)(T.ws + WS_MOD) + (size_t)cond_of_row(R) * NMOD;
    float ss = 0.f; for (int c = tid; c < DM; c += 256) ss += xr[c] * xr[c];
    ss = blk_sum(ss, sh); const float rstd = 1.0f / sqrtf(ss / DM + EPSN); float e2 = 0.f, r2 = 0.f;
    for (int c = tid; c < DM; c += 256) { const float h = xr[c] * rstd * T.norm_pre[c] * (1.0f + m[DM + c]) + m[c]; const float g = bf2f(((const bf16*)(T.ws + WS_H))[(size_t)R * DM + c]); e2 += (g - h) * (g - h); r2 += h * h; }
    dg_accum(diag, e2, r2);
}
__global__ void chk_act(Tens T, const float* W, float* diag) {
    const int i = blockIdx.x * blockDim.x + threadIdx.x; const int ri = i / 256, cj = i % 256; const int R = ri * SAMP_STRIDE, col = cj * 11;
    const bf16* h = (const bf16*)(T.ws + WS_H) + (size_t)R * DM; float g = 0.f, u = 0.f;
    for (int k = 0; k < DM; ++k) { const float a = bf2f(h[k]); g += a * W[(size_t)k * 2 * FFN + col]; u += a * W[(size_t)k * 2 * FFN + FFN + col]; }
    const float e = dsilu(g) * u, got = bf2f(((const bf16*)(T.ws + WS_ACT))[(size_t)R * FFN + col]);
    dg_accum(diag, (got - e) * (got - e), e * e);
}
__global__ void chk_outf(Tens T, const bf16* A, int K, const float* W, float* diag) {
    const int i = blockIdx.x * blockDim.x + threadIdx.x; const int ri = i / 256, cj = i % 256; const int R = ri * SAMP_STRIDE, col = (cj * 5) % DM;
    float s = 0.f; for (int k = 0; k < K; ++k) s += bf2f(A[(size_t)R * K + k]) * W[(size_t)k * DM + col];
    const float got = ((const float*)(T.ws + WS_OUTF))[(size_t)R * DM + col];
    dg_accum(diag, (got - s) * (got - s), s * s);
}
__global__ void chk_post(Tens T, int sub, const float* xstash, float* diag) {
    __shared__ float sh[4];
    const int R = blockIdx.x * SAMP_STRIDE, tid = threadIdx.x; const float* xo = sub == 0 ? xrow_in(T, R) : xstash + (size_t)blockIdx.x * DM;
    const float* o = (const float*)(T.ws + WS_OUTF) + (size_t)R * DM; const float* m = (const float*)(T.ws + WS_MOD) + (size_t)cond_of_row(R) * NMOD;
    const float resw = sub == 1 ? 1.0f : 0.5f;
    float ss = 0.f; for (int c = tid; c < DM; c += 256) ss += o[c] * o[c];
    ss = blk_sum(ss, sh); const float rstd = 1.0f / sqrtf(ss / DM + EPSN);
    float xn[4]; float s2 = 0.f, e2 = 0.f, r2 = 0.f;
    for (int j = 0; j < 4; ++j) { const int c = tid + 256 * j; xn[j] = xo[c] + resw * m[(3 * sub + 2) * DM + c] * (o[c] * rstd * T.norm_post[sub * DM + c]); s2 += xn[j] * xn[j];
        const float g = T.out[(size_t)R * DM + c]; e2 += (g - xn[j]) * (g - xn[j]); r2 += xn[j] * xn[j]; }
    if (sub < 2) { s2 = blk_sum(s2, sh); const float rs2 = 1.0f / sqrtf(s2 / DM + EPSN);
        for (int j = 0; j < 4; ++j) { const int c = tid + 256 * j; const float h = xn[j] * rs2 * T.norm_pre[(sub + 1) * DM + c] * (1.0f + m[(3 * (sub + 1) + 1) * DM + c]) + m[(3 * (sub + 1)) * DM + c];
            const float g = bf2f(((const bf16*)(T.ws + WS_H))[(size_t)R * DM + c]); e2 += (g - h) * (g - h); r2 += h * h; } }
    dg_accum(diag, e2, r2);
}
__global__ void chk_cache(Tens T, float* diag) {
    const int i = blockIdx.x * blockDim.x + threadIdx.x; float e2 = 0.f, r2 = 0.f;
    if (i < 8 * PAST * 128) { const int b = i / (PAST * 128), p = (i / 128) % PAST, c = i % 128;
        const float k = T.cache_k[i], v = T.cache_v[i]; const size_t o = ((size_t)b * TKL + SEQ_L + p) * 128 + c;
        const float gk = bf2f(((const bf16*)(T.ws + WS_KL))[o]), gv = bf2f(((const bf16*)(T.ws + WS_VL))[o]);
        e2 = (gk - k) * (gk - k) + (gv - v) * (gv - v); r2 = k * k + v * v; }
    dg_accum(diag, e2, r2);
}
__device__ __forceinline__ void sincos_d(double a, double& s, double& c) {
    const double TWO_PI = 6.283185307179586476925; a -= TWO_PI * floor(a / TWO_PI + 0.5);
    const double x2 = a * a; double ts = a, tc = 1.0; s = a; c = 1.0;
    for (int k = 1; k < 16; ++k) { tc *= -x2 / ((2.0 * k - 1.0) * (2.0 * k)); ts *= -x2 / ((2.0 * k) * (2.0 * k + 1.0)); c += tc; s += ts; }
}
__global__ void chk_inproj(Tens T, float* diag) {
    __shared__ float proj[INC]; __shared__ float rs[10];
    const int R = blockIdx.x * SAMP_STRIDE, tid = threadIdx.x; const bool lat = R >= NCTX;
    const bf16* h = (const bf16*)(T.ws + WS_H) + (size_t)R * DM;
    for (int col = tid; col < INC; col += 256) { float s = 0.f; for (int k = 0; k < DM; ++k) s += bf2f(h[k]) * T.w_in[(size_t)k * INC + col]; proj[col] = s; }
    __syncthreads();
    if (tid < 10) { float ss = 0.f; for (int d = 0; d < 64; ++d) ss += proj[tid * 64 + d] * proj[tid * 64 + d]; rs[tid] = 1.0f / sqrtf(ss / 64.0f + EPSN); }
    __syncthreads();
    const int Rl = R - NCTX, b = lat ? (Rl >> 12) : (R >> 8), t = lat ? (Rl & 4095) : (R & 255);
    float e2 = 0.f, r2 = 0.f;
    for (int col = tid; col < INC; col += 256) {
        float e, g;
        if (col < 640) {
            const int hd = col >> 6, d = col & 63; const bool isq = hd < 8;
            auto nv = [&](int dd) { return proj[hd * 64 + dd] * rs[hd] * (isq ? T.q_norm[dd] : T.k_norm[dd]); };
            float val = nv(d);
            if (lat) { const int half = d >> 5, dd = d & 31, i = dd & 15; const int pos = half == 0 ? (t >> 6) : (t & 63);
                double th = 1.0; for (int q_ = 0; q_ < i; ++q_) th *= 0.56234132519034908; double sn, cs; sincos_d((double)pos * th, sn, cs);
                const float other = nv(half * 32 + (dd < 16 ? dd + 16 : dd - 16));
                val = dd < 16 ? (float)(val * cs - other * sn) : (float)(val * cs + other * sn); }
            if (isq) { e = val * (0.125f * 1.4426950408889634f); g = bf2f(((const bf16*)(T.ws + WS_Q))[(size_t)R * 512 + col]); }
            else { const int kvh = hd - 8;
                if (lat) { e = val; g = bf2f(((const bf16*)(T.ws + WS_KL))[((size_t)b * TKL + t) * 128 + kvh * 64 + d]); }
                else { e = val; g = bf2f(((const bf16*)(T.ws + WS_KC))[(size_t)R * 128 + kvh * 64 + d]);
                    const float g2 = T.out[(size_t)MTOK * DM + (size_t)R * 128 + kvh * 64 + d]; e2 += (g2 - e) * (g2 - e); r2 += e * e; } }
        } else if (col < 768) { const int c = col - 640; e = proj[col];
            if (lat) g = bf2f(((const bf16*)(T.ws + WS_VL))[((size_t)b * TKL + t) * 128 + c]);
            else { g = bf2f(((const bf16*)(T.ws + WS_VC))[(size_t)R * 128 + c]); const float g2 = T.out[(size_t)MTOK * DM + (size_t)NCTX * 128 + (size_t)R * 128 + c]; e2 += (g2 - e) * (g2 - e); r2 += e * e; }
        } else if (col < 1280) { e = proj[col]; g = bf2f(((const bf16*)(T.ws + WS_XL))[(size_t)R * 512 + col - 768]); }
        else { e = dgelu(proj[col]); g = bf2f(((const bf16*)(T.ws + WS_GL))[(size_t)R * 512 + col - 1280]); }
        e2 += (g - e) * (g - e); r2 += e * e;
    }
    dg_accum(diag, e2, r2);
}
__global__ void chk_lru(Tens T, float* diag) {
    __shared__ float xcs[64];
    const int sb[5] = {3, 7, 0, 17, 31}, sn[5] = {5, 0, 0, 3, 7}; const bool latv[5] = {true, true, false, false, false};
    const int smp = blockIdx.x, b = sb[smp], n = sn[smp], c = threadIdx.x, gc = n * 64 + c; const bool lat = latv[smp];
    const int S = lat ? SEQ_L : SEQ_C, rowbase = lat ? NCTX + b * SEQ_L : b * SEQ_C;
    const bf16* XL = (const bf16*)(T.ws + WS_XL); const bf16* GL = (const bf16*)(T.ws + WS_GL); const bf16* HB = (const bf16*)(T.ws + WS_H);
    float* hf = (float*)(T.ws + WS_OUTF) + (size_t)smp * SEQ_L * 64;
    float e2 = 0.f, r2 = 0.f;
    for (int dir = 0; dir < 2; ++dir) {
        const float sp = log1pf(expf(-T.lru_lambda[dir * 512 + gc]));
        float h = lat ? T.state_lru[(b * 2 + dir) * 512 + gc] : 0.0f;
        for (int s = 0; s < S; ++s) { const int t = dir ? S - 1 - s : s;
            float xc = T.conv_b[gc];
            for (int j = 0; j < 4; ++j) { const int tt = t + j - 2; if (tt >= 0 && tt < S) xc += T.conv_w[j * 512 + gc] * bf2f(XL[(size_t)(rowbase + tt) * 512 + gc]); }
            __syncthreads(); xcs[c] = xc; __syncthreads();
            float ga = T.lru_ba[dir * 512 + gc], gx = T.lru_bx[dir * 512 + gc];
            for (int k = 0; k < 64; ++k) { ga += xcs[k] * T.lru_wa[((size_t)(dir * 8 + n) * 64 + k) * 64 + c]; gx += xcs[k] * T.lru_wx[((size_t)(dir * 8 + n) * 64 + k) * 64 + c]; }
            const float r = 1.0f / (1.0f + expf(-ga)), ig = 1.0f / (1.0f + expf(-gx));
            const float la = -8.0f * r * sp, a = expf(la), bb = sqrtf(-expm1f(2.0f * la)) * (ig * xc);
            h = a * h + bb;
            if (!dir) hf[(size_t)t * 64 + c] = h;
            else { const float e = (hf[(size_t)t * 64 + c] + h) * bf2f(GL[(size_t)(rowbase + t) * 512 + gc]); const float g = bf2f(HB[(size_t)(rowbase + t) * DM + 512 + gc]); e2 += (g - e) * (g - e); r2 += e * e; }
        }
        if (!lat) { const float g = T.out[(size_t)MTOK * DM + (size_t)2 * NCTX * 128 + (size_t)(b * 2 + dir) * 512 + gc]; e2 += 64.0f * (g - h) * (g - h); r2 += 64.0f * h * h; }
    }
    dg_accum(diag, e2, r2);
}
__global__ void chk_attn(Tens T, float* diag) {
    const int wv = (blockIdx.x * blockDim.x + threadIdx.x) >> 6, lane = threadIdx.x & 63; const int ri = wv >> 3, head = wv & 7, kvh = head >> 2; const int R = ri * SAMP_STRIDE; const bool lat = R >= NCTX;
    const int b = lat ? ((R - NCTX) >> 12) : (R >> 8), NK = lat ? TKL : SEQ_C;
    const bf16* K = lat ? (const bf16*)(T.ws + WS_KL) + (size_t)b * TKL * 128 : (const bf16*)(T.ws + WS_KC) + (size_t)b * SEQ_C * 128;
    const bf16* V = lat ? (const bf16*)(T.ws + WS_VL) + (size_t)b * TKL * 128 : (const bf16*)(T.ws + WS_VC) + (size_t)b * SEQ_C * 128;
    const bf16* q = (const bf16*)(T.ws + WS_Q) + (size_t)R * 512 + head * 64;
    float mx = -1e30f;
    for (int k = lane; k < NK; k += 64) { float s = 0.f; for (int d = 0; d < 64; ++d) s += bf2f(q[d]) * bf2f(K[(size_t)k * 128 + kvh * 64 + d]); mx = fmaxf(mx, s); }
#pragma unroll
    for (int o = 1; o < 64; o <<= 1) mx = fmaxf(mx, __shfl_xor(mx, o));
    float l = 0.f; float e2 = 0.f, r2 = 0.f;
    for (int d0 = 0; d0 < 64; d0 += 16) {
        float o[16]; for (int j = 0; j < 16; ++j) o[j] = 0.f; float ll = 0.f;
        for (int k = lane; k < NK; k += 64) { float s = 0.f; for (int d = 0; d < 64; ++d) s += bf2f(q[d]) * bf2f(K[(size_t)k * 128 + kvh * 64 + d]);
            const float p = exp2f(s - mx); ll += p; for (int j = 0; j < 16; ++j) o[j] += p * bf2f(V[(size_t)k * 128 + kvh * 64 + d0 + j]); }
        l = wave_sum(ll);
        for (int j = 0; j < 16; ++j) { const float v = wave_sum(o[j]) / l; const float g = bf2f(((const bf16*)(T.ws + WS_H))[(size_t)R * DM + head * 64 + d0 + j]);
            if (lane == 0) { e2 += (g - v) * (g - v); r2 += v * v; } }
    }
    dg_accum(diag, e2, r2);
}
__global__ void chk_encode(float* out, int out_size, const float* diag, int nstage) {
    __shared__ int sst; __shared__ float sval;
    if (threadIdx.x == 0) { int st = 0; float val = 0.f;
        for (int s = 1; s <= nstage; ++s) { const float e = diag[2 * s], r = diag[2 * s + 1]; const float rv = e / fmaxf(r, 1e-30f);
            if (!(rv < 3e-4f) || !(r > 0.f)) { st = s; int bk = (rv == rv && rv > 0.f) ? (int)floorf(log10f(rv)) + 7 : 9; bk = bk < 0 ? 0 : (bk > 9 ? 9 : bk); val = (float)(10 + s); for (int i = 0; i < 2 + bk; ++i) val *= 10.0f; break; } }
        sst = st; sval = val; }
    __syncthreads();
    if (sst == 0) return;
    for (size_t i = (size_t)blockIdx.x * blockDim.x + threadIdx.x; i < (size_t)out_size; i += (size_t)gridDim.x * blockDim.x) out[i] = (i == (size_t)NCTX * DM) ? sval : 0.0f;
}
#endif

extern "C" void kernel_launch(void* const* d_in, const int* in_sizes, int n_in, void* d_out, int out_size, void* d_ws, size_t ws_size, hipStream_t stream) {
    static int grid = 0;
    if (grid == 0) {
        const int want_out = MTOK * DM + 2 * NCTX * 128 + 32 * 2 * 512;
        if (n_in != 24 || out_size != want_out || ws_size < WS_END) { fprintf(stderr, "kernel_launch: shape mismatch: n_in %d out %d (want %d) ws %zu (need %zu); nothing launched\n", n_in, out_size, want_out, ws_size, (size_t)WS_END); grid = -1; return; }
        int dev = 0, cus = 0, per_cu = 0;
        if (hipGetDevice(&dev) != hipSuccess || hipDeviceGetAttribute(&cus, hipDeviceAttributeMultiprocessorCount, dev) != hipSuccess) { fprintf(stderr, "kernel_launch: device query failed\n"); grid = -1; return; }
        if (hipFuncSetAttribute((const void*)fwd_kernel, hipFuncAttributeMaxDynamicSharedMemorySize, LDS_BYTES) != hipSuccess) { fprintf(stderr, "kernel_launch: hipFuncSetAttribute failed\n"); grid = -1; return; }
        if (hipOccupancyMaxActiveBlocksPerMultiprocessor(&per_cu, (const void*)fwd_kernel, NTHR, LDS_BYTES) != hipSuccess || per_cu < 1) fprintf(stderr, "kernel_launch: note: occupancy query reports %d workgroups per CU\n", per_cu);
        (void)hipGetLastError();
        grid = cus;
    }
    if (grid < 0) return;
    if (hipMemsetAsync((char*)d_ws + WS_CTL, 0, CTL_ZERO_BYTES, stream) != hipSuccess) { fprintf(stderr, "kernel_launch: hipMemsetAsync failed\n"); return; }
    Args a{};
    for (int i = 0; i < 24; ++i) a.in[i] = (const float*)d_in[i];
    a.out = (float*)d_out; a.ws = (unsigned char*)d_ws;
#if !DBG_CHECK
    a.ph_lo = 0; a.ph_hi = NPH; a.li = 0;
    hipLaunchKernelGGL(fwd_kernel, dim3(grid), dim3(NTHR), LDS_BYTES, stream, a);
#else
    Tens T{};
    T.x_prompt = a.in[0]; T.x_sample = a.in[1]; T.c = a.in[2]; T.cache_k = a.in[3]; T.cache_v = a.in[4]; T.state_lru = a.in[5]; T.c_ctx = a.in[6];
    T.w_mod = a.in[7]; T.b_mod = a.in[8]; T.norm_pre = a.in[9]; T.norm_post = a.in[10]; T.ffn_w_in = a.in[11]; T.ffn_w_out = a.in[12]; T.w_in = a.in[13];
    T.w_out = a.in[14]; T.q_norm = a.in[15]; T.k_norm = a.in[16]; T.conv_w = a.in[17]; T.conv_b = a.in[18]; T.lru_wa = a.in[19]; T.lru_ba = a.in[20];
    T.lru_wx = a.in[21]; T.lru_bx = a.in[22]; T.lru_lambda = a.in[23]; T.out = a.out; T.ws = a.ws;
    float* diag = (float*)((char*)d_ws + WS_DIAG);
    (void)hipMemsetAsync(diag, 0, 64 * 4, stream);
    const float* dbgx = (const float*)((char*)d_ws + WS_DBG);
    const bf16* Hb = (const bf16*)((char*)d_ws + WS_H); const bf16* Actb = (const bf16*)((char*)d_ws + WS_ACT);
    for (int ph = 0; ph < NPH; ++ph) {
        a.ph_lo = ph; a.ph_hi = ph + 1; a.li = ph;
        hipLaunchKernelGGL(fwd_kernel, dim3(grid), dim3(NTHR), LDS_BYTES, stream, a);
        switch (ph) {
        case 0: hipLaunchKernelGGL(chk_mod, dim3((9 * NMOD + 255) / 256), dim3(256), 0, stream, T, diag + 2 * 1); break;
        case 1: hipLaunchKernelGGL(chk_pre0, dim3(NSAMP), dim3(256), 0, stream, T, diag + 2 * 2); break;
        case 2: hipLaunchKernelGGL(chk_act, dim3(NSAMP), dim3(256), 0, stream, T, T.ffn_w_in, diag + 2 * 3); break;
        case 3: hipLaunchKernelGGL(chk_outf, dim3(NSAMP), dim3(256), 0, stream, T, Actb, FFN, T.ffn_w_out, diag + 2 * 4); break;
        case 4: hipLaunchKernelGGL(chk_post, dim3(NSAMP), dim3(256), 0, stream, T, 0, dbgx, diag + 2 * 5);
                hipLaunchKernelGGL(chk_cache, dim3(8 * PAST * 128 / 256), dim3(256), 0, stream, T, diag + 2 * 5); break;
        case 5: hipLaunchKernelGGL(chk_inproj, dim3(NSAMP), dim3(256), 0, stream, T, diag + 2 * 6); break;
        case 6: hipLaunchKernelGGL(chk_lru, dim3(5), dim3(64), 0, stream, T, diag + 2 * 7);
                hipLaunchKernelGGL(chk_attn, dim3(NSAMP * 8 * 64 / 256), dim3(256), 0, stream, T, diag + 2 * 8); break;
        case 7: hipLaunchKernelGGL(chk_outf, dim3(NSAMP), dim3(256), 0, stream, T, Hb, DM, T.w_out, diag + 2 * 9); break;
        case 8: hipLaunchKernelGGL(chk_post, dim3(NSAMP), dim3(256), 0, stream, T, 1, dbgx, diag + 2 * 10); break;
        case 9: hipLaunchKernelGGL(chk_act, dim3(NSAMP), dim3(256), 0, stream, T, T.ffn_w_in + (size_t)DM * 2 * FFN, diag + 2 * 11); break;
        case 10: hipLaunchKernelGGL(chk_outf, dim3(NSAMP), dim3(256), 0, stream, T, Actb, FFN, T.ffn_w_out + (size_t)FFN * DM, diag + 2 * 12); break;
        case 11: hipLaunchKernelGGL(chk_post, dim3(NSAMP), dim3(256), 0, stream, T, 2, dbgx + (size_t)64 * DM, diag + 2 * 13); break;
        }
    }
    hipLaunchKernelGGL(chk_encode, dim3(1024), dim3(256), 0, stream, (float*)d_out, out_size, (const float*)diag, 13);
#endif
    const hipError_t le = hipPeekAtLastError();
    if (le != hipSuccess) fprintf(stderr, "kernel_launch: launch failed: %s (grid %d x %d threads, %d B LDS)\n", hipGetErrorName(le), grid, NTHR, LDS_BYTES);
}
```
